# Optimizing an MI355X kernel written in HIP

```python
import math
import jax, jax.numpy as jnp
from jax import lax
import numpy as np

D_MODEL = 2048
BATCH = 2
SEQ = 4096
DEPTH = 2

D_SSM = D_MODEL // 4
D_ATTN = D_MODEL // 2
D_CONV = D_MODEL // 4
D_MIX = D_SSM + D_ATTN + D_CONV
SSM_GROUP = 16
SSM_GROUPS = D_SSM // SSM_GROUP
SSM_STATE = 64
DT_MIN = 0.001
DT_MAX = 0.1
ATTN_HEAD_DIM = 64
ATTN_HEADS = D_ATTN // (2 * ATTN_HEAD_DIM)
ATTN_V_DIM = 2 * ATTN_HEAD_DIM
Q_BLOCK = 128
ROPE_THETA = 10000.0
CONV_WIDTH = 3
D_FF = 5504
N_BRANCH = 3
NORM_EPS = 1e-6
D_IN = D_SSM + 3 * D_ATTN + 3 * D_CONV
SPLITS = tuple(int(s) for s in np.cumsum([D_SSM, D_ATTN, D_ATTN, D_ATTN, D_CONV, D_CONV]))

kernel_name = "hybrid_s5_diffattn_shortconv_macaron"


def rms_norm(x, g):
    xf = x.astype(jnp.float32)
    y = xf * lax.rsqrt(jnp.mean(xf * xf, axis=-1, keepdims=True) + NORM_EPS)
    return (y * g.astype(jnp.float32)).astype(x.dtype)


def swiglu(h, w13, w2):
    a, b = jnp.split(h @ w13, 2, axis=-1)
    return (jax.nn.silu(a) * b) @ w2


def rope_tables(seq_len, dtype):
    pos = jnp.arange(seq_len, dtype=jnp.float32)
    inv = ROPE_THETA ** (-jnp.arange(0, ATTN_HEAD_DIM, 2, dtype=jnp.float32) / ATTN_HEAD_DIM)
    ang = pos[:, None] * inv[None, :]
    return jnp.cos(ang).astype(dtype), jnp.sin(ang).astype(dtype)


def apply_rope(x, cos, sin):
    half = ATTN_HEAD_DIM // 2
    x1, x2 = x[..., :half], x[..., half:]
    c = cos[:, None, None, :]
    s = sin[:, None, None, :]
    return jnp.concatenate([x1 * c - x2 * s, x2 * c + x1 * s], axis=-1)


def _complex_linear_combine(left, right):
    a1r, a1i, b1r, b1i = left
    a2r, a2i, b2r, b2i = right
    ar = a1r * a2r - a1i * a2i
    ai = a1r * a2i + a1i * a2r
    br = a2r * b1r - a2i * b1i + b2r
    bi = a2r * b1i + a2i * b1r + b2i
    return ar, ai, br, bi


def s5_mixer(u, lam_re, lam_im, log_dt, b_re, b_im, c_re, c_im, d_skip, w_glu, b_glu):
    f32 = jnp.float32
    bsz, seq_len, _ = u.shape
    uf = u.astype(f32)
    ug = uf.reshape(bsz, seq_len, SSM_GROUPS, SSM_GROUP)
    bu_re = jnp.einsum('blgh,gnh->blgn', ug, b_re.astype(f32))
    bu_im = jnp.einsum('blgh,gnh->blgn', ug, b_im.astype(f32))
    state_re = jnp.zeros_like(bu_re)
    state_im = jnp.zeros_like(bu_im)
    for direction, rev in ((0, False), (1, True)):
        lr = lam_re[direction].astype(f32)
        li = lam_im[direction].astype(f32)
        dt = jnp.exp(log_dt[direction].astype(f32))[:, None]
        mag = jnp.exp(dt * lr)
        ar = mag * jnp.cos(dt * li)
        ai = mag * jnp.sin(dt * li)
        denom = lr * lr + li * li
        nr = ar - 1.0
        coef_re = (nr * lr + ai * li) / denom
        coef_im = (ai * lr - nr * li) / denom
        bb_re = coef_re * bu_re - coef_im * bu_im
        bb_im = coef_re * bu_im + coef_im * bu_re
        a_re = jnp.broadcast_to(ar, bb_re.shape)
        a_im = jnp.broadcast_to(ai, bb_im.shape)
        _, _, s_re, s_im = lax.associative_scan(
            _complex_linear_combine, (a_re, a_im, bb_re, bb_im), reverse=rev, axis=1)
        state_re = state_re + s_re
        state_im = state_im + s_im
    y = (jnp.einsum('blgn,ghn->blgh', state_re, c_re.astype(f32))
         - jnp.einsum('blgn,ghn->blgh', state_im, c_im.astype(f32)))
    y = y.reshape(bsz, seq_len, D_SSM) + d_skip.astype(f32) * uf
    y = jax.nn.gelu(y)
    y = y * jax.nn.sigmoid(y @ w_glu.astype(f32) + b_glu.astype(f32))
    return y.astype(u.dtype)


def diff_attention(q, k, v, cos, sin, lam_vec, subln_g, lambda_init):
    bsz, seq_len, _ = q.shape
    q = apply_rope(q.reshape(bsz, seq_len, ATTN_HEADS, 2, ATTN_HEAD_DIM), cos, sin)
    k = apply_rope(k.reshape(bsz, seq_len, ATTN_HEADS, 2, ATTN_HEAD_DIM), cos, sin)
    v = v.reshape(bsz, seq_len, ATTN_HEADS, ATTN_V_DIM)
    lv = lam_vec.astype(jnp.float32)
    lam = jnp.exp(jnp.sum(lv[0] * lv[1])) - jnp.exp(jnp.sum(lv[2] * lv[3])) + lambda_init
    scale = ATTN_HEAD_DIM ** -0.5
    n_blocks = seq_len // Q_BLOCK
    qb = q.reshape(bsz, n_blocks, Q_BLOCK, ATTN_HEADS, 2, ATTN_HEAD_DIM).transpose(1, 0, 2, 3, 4, 5)

    def attend_block(q_blk):
        s = jnp.einsum('bqhcd,bkhcd->bhcqk', q_blk, k).astype(jnp.float32) * scale
        p = jax.nn.softmax(s, axis=-1)
        w = p[:, :, 0] - lam * p[:, :, 1]
        return jnp.einsum('bhqk,bkhd->bqhd', w.astype(v.dtype), v)

    o = lax.map(attend_block, qb)
    o = o.transpose(1, 0, 2, 3, 4).reshape(bsz, seq_len, ATTN_HEADS, ATTN_V_DIM)
    o = rms_norm(o, subln_g) * (1.0 - lambda_init)
    return o.reshape(bsz, seq_len, D_ATTN)


def short_conv(bg, cg, xv, conv_w):
    z = cg * xv
    zc = lax.conv_general_dilated(
        z, conv_w[:, None, :].astype(z.dtype), window_strides=(1,),
        padding=((CONV_WIDTH // 2, CONV_WIDTH // 2),),
        dimension_numbers=('NWC', 'WIO', 'NWC'), feature_group_count=D_CONV)
    return bg * zc


def setup_inputs(seed: int = 0) -> dict:
    key = jax.random.key(seed)
    ks = jax.random.split(key, 26)
    f32 = jnp.float32
    nrm = lambda k, shape, s: jax.random.normal(k, shape, f32) * s
    x = jax.random.normal(ks[0], (BATCH, SEQ, D_MODEL), f32)
    norm_w = 1.0 + nrm(ks[1], (DEPTH, 3, D_MODEL), 0.01)
    ffn_w13 = nrm(ks[2], (DEPTH, 2, D_MODEL, 2 * D_FF), D_MODEL ** -0.5)
    ffn_w2 = nrm(ks[3], (DEPTH, 2, D_FF, D_MODEL), D_FF ** -0.5)
    w_in = nrm(ks[4], (DEPTH, D_MODEL, D_IN), D_MODEL ** -0.5)
    s5_lambda_re = -0.5 + nrm(ks[5], (DEPTH, 2, SSM_GROUPS, SSM_STATE), 0.01)
    s5_lambda_im = (math.pi * jnp.arange(SSM_STATE, dtype=f32)
                    + nrm(ks[6], (DEPTH, 2, SSM_GROUPS, SSM_STATE), 0.01))
    s5_log_dt = jax.random.uniform(ks[7], (DEPTH, 2, SSM_GROUPS), f32,
                                   minval=math.log(DT_MIN), maxval=math.log(DT_MAX))
    s5_b_re = nrm(ks[8], (DEPTH, SSM_GROUPS, SSM_STATE, SSM_GROUP), SSM_GROUP ** -0.5)
    s5_b_im = nrm(ks[9], (DEPTH, SSM_GROUPS, SSM_STATE, SSM_GROUP), SSM_GROUP ** -0.5)
    s5_c_re = nrm(ks[10], (DEPTH, SSM_GROUPS, SSM_GROUP, SSM_STATE), SSM_STATE ** -0.5)
    s5_c_im = nrm(ks[11], (DEPTH, SSM_GROUPS, SSM_GROUP, SSM_STATE), SSM_STATE ** -0.5)
    s5_d = nrm(ks[12], (DEPTH, D_SSM), 1.0)
    s5_w_glu = nrm(ks[13], (DEPTH, D_SSM, D_SSM), D_SSM ** -0.5)
    s5_b_glu = nrm(ks[14], (DEPTH, D_SSM), 0.01)
    diff_lambda = nrm(ks[15], (DEPTH, 4, ATTN_HEAD_DIM), 0.1)
    diff_subln = 1.0 + nrm(ks[16], (DEPTH, ATTN_V_DIM), 0.01)
    conv_w = nrm(ks[17], (DEPTH, CONV_WIDTH, D_CONV), CONV_WIDTH ** -0.5)
    w_branch = jnp.concatenate([
        nrm(ks[18], (DEPTH, D_SSM, D_MODEL), D_SSM ** -0.5),
        nrm(ks[19], (DEPTH, D_ATTN, D_MODEL), D_ATTN ** -0.5),
        nrm(ks[20], (DEPTH, D_CONV, D_MODEL), D_CONV ** -0.5)], axis=1)
    w_gate = nrm(ks[21], (DEPTH, D_MODEL, N_BRANCH * D_MODEL), D_MODEL ** -0.5)
    b_gate = nrm(ks[22], (DEPTH, N_BRANCH * D_MODEL), 0.01)
    w_out = nrm(ks[23], (DEPTH, D_MODEL, D_MODEL), D_MODEL ** -0.5)
    final_norm = 1.0 + nrm(ks[24], (D_MODEL,), 0.01)
    return {"x": x, "norm_w": norm_w, "ffn_w13": ffn_w13, "ffn_w2": ffn_w2, "w_in": w_in,
            "s5_lambda_re": s5_lambda_re, "s5_lambda_im": s5_lambda_im, "s5_log_dt": s5_log_dt,
            "s5_b_re": s5_b_re, "s5_b_im": s5_b_im, "s5_c_re": s5_c_re, "s5_c_im": s5_c_im,
            "s5_d": s5_d, "s5_w_glu": s5_w_glu, "s5_b_glu": s5_b_glu,
            "diff_lambda": diff_lambda, "diff_subln": diff_subln, "conv_w": conv_w,
            "w_branch": w_branch, "w_gate": w_gate, "b_gate": b_gate, "w_out": w_out,
            "final_norm": final_norm}


def reference(x, norm_w, ffn_w13, ffn_w2, w_in, s5_lambda_re, s5_lambda_im, s5_log_dt,
              s5_b_re, s5_b_im, s5_c_re, s5_c_im, s5_d, s5_w_glu, s5_b_glu,
              diff_lambda, diff_subln, conv_w, w_branch, w_gate, b_gate, w_out, final_norm):
    bsz, seq_len, _ = x.shape
    cos, sin = rope_tables(seq_len, x.dtype)
    r_a, r_b = D_SSM, D_SSM + D_ATTN
    for l in range(DEPTH):
        lambda_init = 0.8 - 0.6 * math.exp(-0.3 * l)
        x = x + 0.5 * swiglu(rms_norm(x, norm_w[l, 0]), ffn_w13[l, 0], ffn_w2[l, 0])
        h = rms_norm(x, norm_w[l, 1])
        u_ssm, q, k, v, bg, cg, xv = jnp.split(h @ w_in[l], SPLITS, axis=-1)
        y_a = s5_mixer(u_ssm, s5_lambda_re[l], s5_lambda_im[l], s5_log_dt[l],
                       s5_b_re[l], s5_b_im[l], s5_c_re[l], s5_c_im[l],
                       s5_d[l], s5_w_glu[l], s5_b_glu[l])
        y_b = diff_attention(q, k, v, cos, sin, diff_lambda[l], diff_subln[l], lambda_init)
        y_c = short_conv(bg, cg, xv, conv_w[l])
        p_a = y_a @ w_branch[l, :r_a]
        p_b = y_b @ w_branch[l, r_a:r_b]
        p_c = y_c @ w_branch[l, r_b:]
        g = jax.nn.sigmoid(h @ w_gate[l] + b_gate[l]).reshape(bsz, seq_len, N_BRANCH, D_MODEL)
        merged = g[:, :, 0] * p_a + g[:, :, 1] * p_b + g[:, :, 2] * p_c
        x = x + merged @ w_out[l]
        x = x + 0.5 * swiglu(rms_norm(x, norm_w[l, 2]), ffn_w13[l, 1], ffn_w2[l, 1])
    return rms_norm(x, final_norm)
```

```cpp
#include <hip/hip_runtime.h>
#include <hip/hip_cooperative_groups.h>
#include <cstdio>
#include <cmath>
namespace cg = cooperative_groups;

#define LAS __attribute__((address_space(3)))
#define DI __device__ __forceinline__
typedef unsigned short bf16_t;
typedef short bf16x8 __attribute__((ext_vector_type(8)));
typedef short s16x4 __attribute__((ext_vector_type(4)));
typedef float f32x4 __attribute__((ext_vector_type(4)));
typedef float f32x16 __attribute__((ext_vector_type(16)));
typedef unsigned u32x4 __attribute__((ext_vector_type(4)));
typedef unsigned u32x2 __attribute__((ext_vector_type(2)));

constexpr int SEQ = 4096, M = 8192, DM = 2048, DFF = 5504, DSSM = 512, DATT = 1024, DCONV = 512, DIN = 5120, NGATE = 6144, NCOMB = DIN + NGATE, DEPTH = 2;
constexpr int LDS_BYTES = 147456, LDS_MISC = 147456 - 64;
constexpr float C2 = 0.125f * 1.4426950408889634f;

constexpr size_t al256(size_t x) { return (x + 255) & ~(size_t)255; }
constexpr size_t SZ_W13T = (size_t)2 * DFF * DM * 2, SZ_W2T = (size_t)DM * DFF * 2, SZ_WCOMB = (size_t)NCOMB * DM * 2, SZ_WGLU = (size_t)DSSM * DSSM * 2;
constexpr size_t SZ_WBR = (size_t)DM * DM * 2, SZ_WOUT = (size_t)DM * DM * 2;
constexpr size_t WS_W13T = 0;
constexpr size_t WS_W2T = WS_W13T + 4 * SZ_W13T;
constexpr size_t WS_WCOMB = WS_W2T + 4 * SZ_W2T;
constexpr size_t WS_WGLU = WS_WCOMB + 2 * SZ_WCOMB;
constexpr size_t WS_WBR = WS_WGLU + 2 * SZ_WGLU;
constexpr size_t WS_WOUT = WS_WBR + 2 * SZ_WBR;
constexpr size_t WS_ROPE = WS_WOUT + 2 * SZ_WOUT;
constexpr size_t WS_X = WS_ROPE + (size_t)2 * SEQ * 32 * 4;
constexpr size_t WS_H = WS_X + (size_t)M * DM * 4;
constexpr size_t WS_ACT = WS_H + (size_t)M * DM * 2;
constexpr size_t WS_U = WS_ACT + (size_t)M * DFF * 2;
constexpr size_t WS_Q = WS_U + (size_t)M * DSSM * 4;
constexpr size_t WS_K = WS_Q + (size_t)M * DATT * 2;
constexpr size_t WS_V = WS_K + (size_t)M * DATT * 2;
constexpr size_t WS_BG = WS_V + (size_t)M * DATT * 2;
constexpr size_t WS_CG = WS_BG + (size_t)M * DCONV * 2;
constexpr size_t WS_XV = WS_CG + (size_t)M * DCONV * 2;
constexpr size_t WS_GATE = WS_XV + (size_t)M * DCONV * 2;
constexpr size_t WS_YG = WS_GATE + (size_t)M * NGATE * 2;
constexpr size_t WS_YA = WS_YG + (size_t)M * DSSM * 2;
constexpr size_t WS_YB = WS_YA + (size_t)M * DSSM * 2;
constexpr size_t WS_YC = WS_YB + (size_t)M * DATT * 2;
constexpr size_t WS_MF = WS_YC + (size_t)M * DCONV * 2;
constexpr size_t WS_MB = WS_MF + (size_t)M * DM * 4;
constexpr size_t WS_SE = WS_MB + (size_t)M * DM * 2;
constexpr size_t WS_BAR = WS_SE + (size_t)4096 * 256 * 4;
constexpr size_t WS_END = WS_BAR + 16384;

typedef float f32x2_t __attribute__((ext_vector_type(2))); typedef __bf16 bf16x2_t __attribute__((ext_vector_type(2)));
DI unsigned pk2(float lo, float hi) { f32x2_t v = {lo, hi}; bf16x2_t b = __builtin_convertvector(v, bf16x2_t); return __builtin_bit_cast(unsigned, b); }
DI float bflo(unsigned w) { return __uint_as_float(w << 16); }
DI float bfhi(unsigned w) { return __uint_as_float(w & 0xffff0000u); }
DI float wave_sum(float v) {
#pragma unroll
    for (int o = 1; o < 64; o <<= 1) v += __shfl_xor(v, o);
    return v;
}
DI float sigmoidf_(float x) { return __builtin_amdgcn_rcpf(1.0f + __builtin_amdgcn_exp2f(-1.4426950408889634f * x)); }
DI float siluf_(float x) { return x * sigmoidf_(x); }
DI float gelu_tanh(float y) { const float z = 0.7978845608028654f * (y + 0.044715f * y * y * y); const float t = 1.0f - 2.0f / (1.0f + __expf(2.0f * z)); return 0.5f * y * (1.0f + t); }
#define LDS_WAIT() asm volatile("s_waitcnt lgkmcnt(0)" ::: "memory")

namespace pg8 {
constexpr int BM = 256, BK = 64, HALF = 128, HTB = HALF * BK * 2, STAGE_BYTES = 8 * HTB, NXCD = 8, WGM = 8;
DI int lds_byte(int r, int c) { const int st = (r >> 4) * 2 + (c >> 5), rr = r & 15, cc = c & 31, ob = rr * 64 + cc * 2; return st * 1024 + (ob ^ (((ob >> 9) & 1) << 5)); }
DI void stage_rc(int b, int& R, int& C) { const int st = b / 1024, sb = b % 1024, swz = sb ^ (((sb >> 9) & 1) << 5); R = (st >> 1) * 16 + swz / 64; C = (st & 1) * 32 + (swz % 64) / 2; }
DI int perm32(int rho) { const int n = rho >> 4, i = rho & 15; return 8 * (i >> 2) + 4 * n + (i & 3); }
struct Unit { int pm, pn; };
struct Gemm { const bf16_t* A; const bf16_t* Bt; int M, N, K; };
struct StaticOrder {
    int nM, nN, nwg, G, c;
    DI void init(int M_, int N_, int G_, int c_) { nM = M_ / BM; nN = N_ / BM; nwg = nM * nN; G = G_; c = c_; }
    DI bool next(int i, Unit& u) const {
        const long L = (long)i * G + c; if (L >= nwg) return false;
        int wgid = (int)L; { const int q = nwg / NXCD, r = nwg % NXCD, xcd = wgid % NXCD, off = wgid / NXCD; wgid = (xcd < r ? xcd * (q + 1) : r * (q + 1) + (xcd - r) * q) + off; }
        const int nig = WGM * nN, gid = wgid / nig, fm = gid * WGM, gsz = (nM - fm) < WGM ? (nM - fm) : WGM;
        u.pm = fm + ((wgid % nig) % gsz); u.pn = (wgid % nig) / gsz; return true;
    }
};
template <class Epi, bool ALIGN_EPI = true, bool SP2 = true>
DI void gemm_phase(LAS unsigned char* lds, const Gemm g, const StaticOrder& S, const Epi& E) {
    int tid_ = threadIdx.x; asm volatile("" : "+v"(tid_));
    const int tid = tid_, wid = __builtin_amdgcn_readfirstlane(tid >> 6), lane = tid & 63, wr = wid >> 2, wc = wid & 3, fr = lane & 15, fq = lane >> 4;
    const int K = g.K, nt = K / BK;
    unsigned voffA[2], voffB[2];
#pragma unroll
    for (int i = 0; i < 2; ++i) { int R, C; stage_rc(tid * 16 + i * 8192, R, C); const int Rb = Epi::PERM ? ((R & ~31) + perm32(R & 31)) : R;
        voffA[i] = (unsigned)(R * K + C) * 2u; voffB[i] = (unsigned)(Rb * K + C) * 2u; }
    const size_t kstep = (size_t)(BK * 2);
    const size_t hstep = (size_t)HALF * K * 2;
    const size_t tstep = 2 * hstep;
    const unsigned ldsw = (unsigned)wid * 1024u;
    const int aoff = lds_byte(wr * 64 + fr, fq * 8), boff = lds_byte(wc * 32 + fr, fq * 8);
#define PG8_SA(b, h) (((b) * 2 + (h)) * HTB)
#define PG8_SB(b, h) ((4 + (b) * 2 + (h)) * HTB)
#define PG8_STAGE(bufoff, gbase, voff) do { _Pragma("unroll") for (int _i = 0; _i < 2; ++_i) \
        __builtin_amdgcn_global_load_lds((const unsigned*)((const char*)(gbase) + (voff)[_i]), (LAS unsigned*)(lds + (bufoff) + ldsw + _i * 8192), 16, 0, 0); } while (0)
#define PG8_LDA(dst, b, h) do { _Pragma("unroll") for (int m = 0; m < 4; ++m) _Pragma("unroll") for (int k = 0; k < 2; ++k) dst[m][k] = *(const LAS bf16x8*)(lds + PG8_SA(b, h) + aoff + m * 2048 + k * 1024); } while (0)
#define PG8_LDB(dst, b, h) do { _Pragma("unroll") for (int n = 0; n < 2; ++n) _Pragma("unroll") for (int k = 0; k < 2; ++k) dst[n][k] = *(const LAS bf16x8*)(lds + PG8_SB(b, h) + boff + n * 2048 + k * 1024); } while (0)
#define PG8_MMA(ai, bj, At, Bt) do { __builtin_amdgcn_s_setprio(1); _Pragma("unroll") for (int m = 0; m < 4; ++m) _Pragma("unroll") for (int n = 0; n < 2; ++n) _Pragma("unroll") for (int k = 0; k < 2; ++k) \
        acc[ai][bj][m][n] = __builtin_amdgcn_mfma_f32_16x16x32_bf16(Bt[n][k], At[m][k], acc[ai][bj][m][n], 0, 0, 0); __builtin_amdgcn_s_setprio(0); } while (0)
#define PG8_WAIT_V(n) asm volatile("s_waitcnt vmcnt(" #n ")" ::: "memory")
#define PG8_WAIT_L(n) asm volatile("s_waitcnt lgkmcnt(" #n ")" ::: "memory")
#define PG8_BAR __builtin_amdgcn_s_barrier()
#define PG8_SCHED __builtin_amdgcn_sched_barrier(0)
    Unit cur, nxt; int ui = 0;
    if (!S.next(0, cur)) return;
    f32x4 acc[2][2][4][2];
#pragma unroll
    for (int a = 0; a < 2; ++a)
#pragma unroll
        for (int b = 0; b < 2; ++b)
#pragma unroll
            for (int m = 0; m < 4; ++m)
#pragma unroll
                for (int n = 0; n < 2; ++n) acc[a][b][m][n] = (f32x4){0.f, 0.f, 0.f, 0.f};
    bf16x8 At[4][2], B0[2][2], B1[2][2];
    const char* cA = (const char*)g.A + (size_t)cur.pm * tstep; const char* cB = (const char*)g.Bt + (size_t)cur.pn * tstep;
    if constexpr (SP2) {
        PG8_STAGE(PG8_SB(0, 0), cB, voffB); PG8_STAGE(PG8_SB(0, 1), cB + hstep, voffB); PG8_STAGE(PG8_SA(0, 0), cA, voffA); PG8_STAGE(PG8_SA(0, 1), cA + hstep, voffA);
        if (wr == 1) PG8_BAR;
        PG8_WAIT_V(2); PG8_BAR;
        PG8_STAGE(PG8_SB(1, 0), cB + kstep, voffB); PG8_STAGE(PG8_SA(1, 0), cA + kstep, voffA); PG8_STAGE(PG8_SB(1, 1), cB + hstep + kstep, voffB);
        PG8_WAIT_V(6); PG8_BAR;
    } else {
        PG8_STAGE(PG8_SB(0, 0), cB, voffB); PG8_STAGE(PG8_SA(0, 0), cA, voffA); PG8_STAGE(PG8_SB(0, 1), cB + hstep, voffB); PG8_STAGE(PG8_SA(0, 1), cA + hstep, voffA);
        if (wr == 1) PG8_BAR;
        PG8_WAIT_V(4); PG8_BAR;
        PG8_STAGE(PG8_SB(1, 0), cB + kstep, voffB); PG8_STAGE(PG8_SA(1, 0), cA + kstep, voffA); PG8_STAGE(PG8_SB(1, 1), cB + hstep + kstep, voffB);
        PG8_WAIT_V(6); PG8_BAR;
    }
    for (;;) {
        const bool has_next = S.next(ui + 1, nxt);
        const char* nA = has_next ? (const char*)g.A + (size_t)nxt.pm * tstep : cA; const char* nB = has_next ? (const char*)g.Bt + (size_t)nxt.pn * tstep : cB;
        for (int t = 0; t < nt; t += 2) {
            const bool last = (t == nt - 2);
            const char* a1 = cA + (size_t)(t + 1) * kstep;
            const char* a2 = last ? nA : cA + (size_t)(t + 2) * kstep; const char* b2 = last ? nB : cB + (size_t)(t + 2) * kstep;
            const char* a3 = a2 + kstep; const char* b3 = b2 + kstep;
            if constexpr (SP2) {
            PG8_LDB(B0, 0, 0); PG8_LDB(B1, 0, 1); PG8_SCHED; PG8_LDA(At, 0, 0); PG8_STAGE(PG8_SA(1, 1), a1 + hstep, voffA);
            PG8_WAIT_V(8); PG8_WAIT_L(0); PG8_BAR; PG8_MMA(0, 0, At, B0); PG8_MMA(0, 1, At, B1); PG8_BAR; PG8_SCHED;
            PG8_LDA(At, 0, 1); PG8_STAGE(PG8_SB(0, 0), b2, voffB); PG8_STAGE(PG8_SB(0, 1), b2 + hstep, voffB); PG8_STAGE(PG8_SA(0, 0), a2, voffA);
            PG8_WAIT_V(8); PG8_WAIT_L(0); PG8_BAR; PG8_MMA(1, 0, At, B0); PG8_MMA(1, 1, At, B1); PG8_BAR; PG8_SCHED;
            PG8_LDB(B0, 1, 0); PG8_LDB(B1, 1, 1); PG8_SCHED; PG8_LDA(At, 1, 0); PG8_STAGE(PG8_SA(0, 1), a2 + hstep, voffA);
            PG8_WAIT_V(8); PG8_WAIT_L(0); PG8_BAR; PG8_MMA(0, 0, At, B0); PG8_MMA(0, 1, At, B1); PG8_BAR; PG8_SCHED;
            PG8_LDA(At, 1, 1); PG8_STAGE(PG8_SB(1, 0), b3, voffB); PG8_STAGE(PG8_SB(1, 1), b3 + hstep, voffB); PG8_STAGE(PG8_SA(1, 0), a3, voffA);
            PG8_WAIT_V(8); PG8_WAIT_L(0); PG8_BAR; PG8_MMA(1, 0, At, B0); PG8_MMA(1, 1, At, B1); PG8_BAR; PG8_SCHED;
            } else {
            PG8_LDB(B0, 0, 0); PG8_SCHED; PG8_LDA(At, 0, 0); PG8_STAGE(PG8_SA(1, 1), a1 + hstep, voffA);
            PG8_WAIT_L(8); PG8_BAR; PG8_WAIT_L(0); PG8_MMA(0, 0, At, B0); PG8_BAR; PG8_SCHED;
            PG8_LDB(B1, 0, 1); PG8_STAGE(PG8_SB(0, 0), b2, voffB);
            PG8_BAR; PG8_WAIT_L(0); PG8_MMA(0, 1, At, B1); PG8_BAR;
            PG8_LDA(At, 0, 1); PG8_STAGE(PG8_SA(0, 0), a2, voffA);
            PG8_BAR; PG8_WAIT_L(0); PG8_MMA(1, 0, At, B0); PG8_BAR; PG8_SCHED;
            PG8_STAGE(PG8_SB(0, 1), b2 + hstep, voffB);
            PG8_WAIT_V(6); PG8_BAR; PG8_MMA(1, 1, At, B1); PG8_BAR;
            PG8_LDB(B0, 1, 0); PG8_SCHED; PG8_LDA(At, 1, 0); PG8_STAGE(PG8_SA(0, 1), a2 + hstep, voffA);
            PG8_WAIT_L(8); PG8_BAR; PG8_WAIT_L(0); PG8_MMA(0, 0, At, B0); PG8_BAR; PG8_SCHED;
            PG8_LDB(B1, 1, 1); PG8_STAGE(PG8_SB(1, 0), b3, voffB);
            PG8_BAR; PG8_WAIT_L(0); PG8_MMA(0, 1, At, B1); PG8_BAR;
            PG8_LDA(At, 1, 1); PG8_STAGE(PG8_SA(1, 0), a3, voffA);
            PG8_BAR; PG8_WAIT_L(0); PG8_MMA(1, 0, At, B0); PG8_BAR; PG8_SCHED;
            PG8_STAGE(PG8_SB(1, 1), b3 + hstep, voffB);
            PG8_WAIT_V(6); PG8_BAR; PG8_MMA(1, 1, At, B1); PG8_BAR;
            }
        }
        if constexpr (ALIGN_EPI) { if (wr == 0) PG8_BAR; }
        E(acc, cur, wr, wc, fr, fq);
        if (!has_next) break;
#pragma unroll
        for (int a = 0; a < 2; ++a)
#pragma unroll
            for (int b = 0; b < 2; ++b)
#pragma unroll
                for (int m = 0; m < 4; ++m)
#pragma unroll
                    for (int n = 0; n < 2; ++n) acc[a][b][m][n] = (f32x4){0.f, 0.f, 0.f, 0.f};
        cur = nxt; cA = nA; cB = nB; ++ui;
        if constexpr (ALIGN_EPI) { if (wr == 1) PG8_BAR; }
    }
    PG8_WAIT_V(0);
    if constexpr (!ALIGN_EPI) { if (wr == 0) PG8_BAR; }
    PG8_BAR;
#undef PG8_SA
#undef PG8_SB
#undef PG8_STAGE
#undef PG8_LDA
#undef PG8_LDB
#undef PG8_MMA
#undef PG8_WAIT_V
#undef PG8_WAIT_L
#undef PG8_BAR
#undef PG8_SCHED
}
typedef f32x4 Acc[2][2][4][2];

struct EpiSwiglu {
    static constexpr bool PERM = true; bf16_t* O;
    DI void operator()(const Acc& acc, const Unit& u, int wr, int wc, int fr, int fq) const {
        const int row0 = u.pm * BM + wr * 64 + fr, col0 = u.pn * 128 + wc * 32 + 8 * fq;
#pragma unroll
        for (int ai = 0; ai < 2; ++ai)
#pragma unroll
            for (int m = 0; m < 4; ++m) {
                bf16_t* rowp = O + (size_t)(row0 + ai * HALF + m * 16) * DFF + col0;
                const f32x4 a0 = acc[ai][0][m][0], a1 = acc[ai][0][m][1], b0 = acc[ai][1][m][0], b1 = acc[ai][1][m][1];
                float v[8];
#pragma unroll
                for (int e = 0; e < 4; ++e) { v[e] = siluf_(a0[e]) * b0[e]; v[4 + e] = siluf_(a1[e]) * b1[e]; }
                u32x4 w; w.x = pk2(v[0], v[1]); w.y = pk2(v[2], v[3]); w.z = pk2(v[4], v[5]); w.w = pk2(v[6], v[7]);
                *(u32x4*)rowp = w;
            }
    }
};
struct EpiResid {
    static constexpr bool PERM = false; const float* src; float* dst; float scale;
    DI void operator()(const Acc& acc, const Unit& u, int wr, int wc, int fr, int fq) const {
        const int row0 = u.pm * BM + wr * 64 + fr, col0 = u.pn * BM + wc * 32 + 4 * fq;
        constexpr int ER_D = 3;
        f32x4 ring[ER_D][4];
#define ER_LOAD(dstv, g) do { const size_t off_ = (size_t)(row0 + ((g) >> 2) * HALF + ((g) & 3) * 16) * DM + col0; \
        _Pragma("unroll") for (int q_ = 0; q_ < 4; ++q_) dstv[q_] = *(const f32x4*)(src + off_ + (q_ >> 1) * HALF + (q_ & 1) * 16); } while (0)
#pragma unroll
        for (int g = 0; g < ER_D; ++g) ER_LOAD(ring[g], g);
#pragma unroll
        for (int g = 0; g < 8; ++g) {
            const size_t off = (size_t)(row0 + (g >> 2) * HALF + (g & 3) * 16) * DM + col0;
            f32x4 o[4];
#pragma unroll
            for (int q = 0; q < 4; ++q) o[q] = ring[g % ER_D][q] + acc[g >> 2][q >> 1][g & 3][q & 1] * scale;
            if (g + ER_D < 8) ER_LOAD(ring[g % ER_D], g + ER_D);
#pragma unroll
            for (int q = 0; q < 4; ++q) *(f32x4*)(dst + off + (q >> 1) * HALF + (q & 1) * 16) = o[q];
        }
#undef ER_LOAD
    }
};
struct EpiInGate {
    static constexpr bool PERM = true;
    unsigned char* ws; const float* bgate;
    DI void operator()(const Acc& acc, const Unit& u, int wr, int wc, int fr, int fq) const {
        const int pn = u.pn, row0 = u.pm * BM + wr * 64 + fr, cl0 = wc * 32 + 8 * fq;
        float* U = (float*)(ws + WS_U); bf16_t* GATE = (bf16_t*)(ws + WS_GATE); const float* COS = (const float*)(ws + WS_ROPE); const float* SIN = COS + SEQ * 32;
        if (pn < 2) {
#pragma unroll
            for (int ai = 0; ai < 2; ++ai)
#pragma unroll
                for (int m = 0; m < 4; ++m) { float* rowp = U + (size_t)(row0 + ai * HALF + m * 16) * DSSM + pn * 256 + cl0;
#pragma unroll
                    for (int bj = 0; bj < 2; ++bj)
#pragma unroll
                        for (int n = 0; n < 2; ++n) *(f32x4*)(rowp + bj * HALF + 4 * n) = acc[ai][bj][m][n]; }
        } else if (pn < 10) {
            const bool isq = pn < 6; const int tq = isq ? pn - 2 : pn - 6; bf16_t* dst = (bf16_t*)(ws + (isq ? WS_Q : WS_K)); const float sc = isq ? C2 : 1.0f;
            const int hc = 4 * tq + wc, d0 = 8 * fq;
#pragma unroll
            for (int ai = 0; ai < 2; ++ai)
#pragma unroll
                for (int m = 0; m < 4; ++m) { const int row = row0 + ai * HALF + m * 16, pos = row & (SEQ - 1);
                    const f32x4 c0 = *(const f32x4*)(COS + pos * 32 + d0), c1 = *(const f32x4*)(COS + pos * 32 + d0 + 4);
                    const f32x4 s0 = *(const f32x4*)(SIN + pos * 32 + d0), s1 = *(const f32x4*)(SIN + pos * 32 + d0 + 4);
                    const f32x4 x10 = acc[ai][0][m][0], x11 = acc[ai][0][m][1], x20 = acc[ai][1][m][0], x21 = acc[ai][1][m][1];
                    const f32x4 o10 = (x10 * c0 - x20 * s0) * sc, o11 = (x11 * c1 - x21 * s1) * sc, o20 = (x20 * c0 + x10 * s0) * sc, o21 = (x21 * c1 + x11 * s1) * sc;
                    bf16_t* rp = dst + (size_t)row * DATT + hc * 64 + d0;
                    u32x4 w; w.x = pk2(o10[0], o10[1]); w.y = pk2(o10[2], o10[3]); w.z = pk2(o11[0], o11[1]); w.w = pk2(o11[2], o11[3]); *(u32x4*)rp = w;
                    w.x = pk2(o20[0], o20[1]); w.y = pk2(o20[2], o20[3]); w.z = pk2(o21[0], o21[1]); w.w = pk2(o21[2], o21[3]); *(u32x4*)(rp + 32) = w; }
        } else if (pn < 20) {
            bf16_t* dst; int pitch, colt;
            if (pn < 14) { dst = (bf16_t*)(ws + WS_V); pitch = DATT; colt = (pn - 10) * 256; }
            else { const int which = (pn - 14) >> 1; dst = (bf16_t*)(ws + WS_BG + (size_t)which * (WS_CG - WS_BG)); pitch = DCONV; colt = ((pn - 14) & 1) * 256; }
#pragma unroll
            for (int ai = 0; ai < 2; ++ai)
#pragma unroll
                for (int m = 0; m < 4; ++m) { bf16_t* rp = dst + (size_t)(row0 + ai * HALF + m * 16) * pitch + colt + cl0;
#pragma unroll
                    for (int bj = 0; bj < 2; ++bj) { const f32x4 v0 = acc[ai][bj][m][0], v1 = acc[ai][bj][m][1];
                        u32x4 w; w.x = pk2(v0[0], v0[1]); w.y = pk2(v0[2], v0[3]); w.z = pk2(v1[0], v1[1]); w.w = pk2(v1[2], v1[3]); *(u32x4*)(rp + bj * HALF) = w; } }
        } else {
            const int gc0 = (pn - 20) * 256 + cl0;
            f32x4 bv[2][2];
#pragma unroll
            for (int bj = 0; bj < 2; ++bj)
#pragma unroll
                for (int n = 0; n < 2; ++n) bv[bj][n] = *(const f32x4*)(bgate + gc0 + bj * HALF + 4 * n);
#pragma unroll
            for (int ai = 0; ai < 2; ++ai)
#pragma unroll
                for (int m = 0; m < 4; ++m) { bf16_t* rp = GATE + (size_t)(row0 + ai * HALF + m * 16) * NGATE + gc0;
#pragma unroll
                    for (int bj = 0; bj < 2; ++bj) { const f32x4 v0 = acc[ai][bj][m][0] + bv[bj][0], v1 = acc[ai][bj][m][1] + bv[bj][1];
                        u32x4 w; w.x = pk2(sigmoidf_(v0[0]), sigmoidf_(v0[1])); w.y = pk2(sigmoidf_(v0[2]), sigmoidf_(v0[3]));
                        w.z = pk2(sigmoidf_(v1[0]), sigmoidf_(v1[1])); w.w = pk2(sigmoidf_(v1[2]), sigmoidf_(v1[3])); *(u32x4*)(rp + bj * HALF) = w; } }
        }
    }
};
struct EpiGLU {
    static constexpr bool PERM = true; const bf16_t* YG; bf16_t* YA; const float* bias;
    DI void operator()(const Acc& acc, const Unit& u, int wr, int wc, int fr, int fq) const {
        const int row0 = u.pm * BM + wr * 64 + fr, col0 = u.pn * BM + wc * 32 + 8 * fq;
        f32x4 bv[2][2];
#pragma unroll
        for (int bj = 0; bj < 2; ++bj) { bv[bj][0] = *(const f32x4*)(bias + col0 + bj * HALF); bv[bj][1] = *(const f32x4*)(bias + col0 + bj * HALF + 4); }
        u32x4 cur[2], nxt[2];
#define EG_LOAD(dstv, g) do { const size_t off_ = (size_t)(row0 + ((g) >> 2) * HALF + ((g) & 3) * 16) * DSSM + col0; dstv[0] = *(const u32x4*)(YG + off_); dstv[1] = *(const u32x4*)(YG + off_ + HALF); } while (0)
        EG_LOAD(cur, 0);
#pragma unroll
        for (int g = 0; g < 8; ++g) {
            if (g < 7) EG_LOAD(nxt, g + 1);
            const size_t off = (size_t)(row0 + (g >> 2) * HALF + (g & 3) * 16) * DSSM + col0;
#pragma unroll
            for (int bj = 0; bj < 2; ++bj) { const u32x4 y = cur[bj];
                const f32x4 v0 = acc[g >> 2][bj][g & 3][0] + bv[bj][0], v1 = acc[g >> 2][bj][g & 3][1] + bv[bj][1];
                u32x4 w; w.x = pk2(bflo(y.x) * sigmoidf_(v0[0]), bfhi(y.x) * sigmoidf_(v0[1])); w.y = pk2(bflo(y.y) * sigmoidf_(v0[2]), bfhi(y.y) * sigmoidf_(v0[3]));
                w.z = pk2(bflo(y.z) * sigmoidf_(v1[0]), bfhi(y.z) * sigmoidf_(v1[1])); w.w = pk2(bflo(y.w) * sigmoidf_(v1[2]), bfhi(y.w) * sigmoidf_(v1[3]));
                *(u32x4*)(YA + off + bj * HALF) = w; }
            cur[0] = nxt[0]; cur[1] = nxt[1];
        }
#undef EG_LOAD
    }
};
template <int IDX> struct EpiBranch {
    static constexpr bool PERM = true; const bf16_t* GATE; float* MF; bf16_t* MB;
    DI void operator()(const Acc& acc, const Unit& u, int wr, int wc, int fr, int fq) const {
        const int row0 = u.pm * BM + wr * 64 + fr, col0 = u.pn * BM + wc * 32 + 8 * fq;
        u32x4 gcur[2], gnxt[2], mcur[2], mnxt[2];
#define EB_LOAD(gd, md, g) do { const int row_ = row0 + ((g) >> 2) * HALF + ((g) & 3) * 16; \
        _Pragma("unroll") for (int bj_ = 0; bj_ < 2; ++bj_) { gd[bj_] = *(const u32x4*)(GATE + (size_t)row_ * NGATE + IDX * DM + col0 + bj_ * HALF); \
            if (IDX > 0) md[bj_] = *(const u32x4*)(MB + (size_t)row_ * DM + col0 + bj_ * HALF); } } while (0)
        EB_LOAD(gcur, mcur, 0);
#pragma unroll
        for (int g = 0; g < 8; ++g) {
            if (g < 7) EB_LOAD(gnxt, mnxt, g + 1);
            const int row = row0 + (g >> 2) * HALF + (g & 3) * 16;
#pragma unroll
            for (int bj = 0; bj < 2; ++bj) { const int col = col0 + bj * HALF; const u32x4 gw = gcur[bj];
                f32x4 v0 = acc[g >> 2][bj][g & 3][0], v1 = acc[g >> 2][bj][g & 3][1];
                v0[0] *= bflo(gw.x); v0[1] *= bfhi(gw.x); v0[2] *= bflo(gw.y); v0[3] *= bfhi(gw.y);
                v1[0] *= bflo(gw.z); v1[1] *= bfhi(gw.z); v1[2] *= bflo(gw.w); v1[3] *= bfhi(gw.w);
                if (IDX > 0) { const u32x4 pm_ = mcur[bj];
                    v0[0] += bflo(pm_.x); v0[1] += bfhi(pm_.x); v0[2] += bflo(pm_.y); v0[3] += bfhi(pm_.y);
                    v1[0] += bflo(pm_.z); v1[1] += bfhi(pm_.z); v1[2] += bflo(pm_.w); v1[3] += bfhi(pm_.w); }
                u32x4 w; w.x = pk2(v0[0], v0[1]); w.y = pk2(v0[2], v0[3]); w.z = pk2(v1[0], v1[1]); w.w = pk2(v1[2], v1[3]);
                *(u32x4*)(MB + (size_t)row * DM + col) = w; }
            gcur[0] = gnxt[0]; gcur[1] = gnxt[1];
            if (IDX > 0) { mcur[0] = mnxt[0]; mcur[1] = mnxt[1]; }
        }
#undef EB_LOAD
    }
};
}

DI void transpose_item(const float* W, int ldw, int K, bf16_t* WT, LAS float* scr, int k0, int nsrc0, int ndst0, int lane) {
#pragma unroll 8
    for (int i = 0; i < 32; ++i) { const int kk = 2 * i + (lane >> 5); scr[kk * 33 + (lane & 31)] = W[(size_t)(k0 + kk) * ldw + nsrc0 + (lane & 31)]; }
    LDS_WAIT();
    const int c = lane & 7;
#pragma unroll
    for (int j = 0; j < 4; ++j) { const int n = (lane >> 3) + 8 * j; const LAS float* s = scr + (8 * c) * 33 + n;
        u32x4 o; o.x = pk2(s[0 * 33], s[1 * 33]); o.y = pk2(s[2 * 33], s[3 * 33]); o.z = pk2(s[4 * 33], s[5 * 33]); o.w = pk2(s[6 * 33], s[7 * 33]);
        *(u32x4*)(WT + (size_t)(ndst0 + n) * K + k0 + 8 * c) = o; }
    LDS_WAIT();
}
DI void conv_matrix(const float* W, int ldw, int K, int Ndst, bf16_t* WT, int kind, int gw, int NGW, LAS float* scr, int lane) {
    const int nblk = Ndst / 32, nitems = (K / 64) * nblk;
    for (int it = gw; it < nitems; it += NGW) {
        const int kb = it / nblk, nb = it - kb * nblk, n = 32 * nb; int src = n;
        if (kind == 1) { const int pn = n >> 8, r = n & 255; src = (r < 128) ? 128 * pn + r : DFF + 128 * pn + (r - 128); }
        else if (kind == 2) { if (n >= 512 && n < 2560) { const int n1 = n - 512, t = n1 >> 8, r = n1 & 255, half = r >> 7, i = r & 127, hcl = i >> 5; src = 512 + 256 * t + 64 * hcl + 32 * half; } }
        transpose_item(W, ldw, K, WT, scr, 64 * kb, src, n, lane);
    }
}

template <bool OUT_F32>
DI void norm_rows(const float* X, const float* g, void* out, int gw, int NGW, int lane) {
    for (int m = gw; m < M; m += NGW) {
        const f32x4* xr = (const f32x4*)(X + (size_t)m * DM) + lane;
        f32x4 v[8]; float s = 0.f;
#pragma unroll
        for (int j = 0; j < 8; ++j) { v[j] = xr[64 * j]; s += (v[j][0] * v[j][0] + v[j][1] * v[j][1]) + (v[j][2] * v[j][2] + v[j][3] * v[j][3]); }
        f32x4 gvv[8];
#pragma unroll
        for (int j = 0; j < 8; ++j) gvv[j] = ((const f32x4*)g)[64 * j + lane];
        const float r = 1.0f / sqrtf(wave_sum(s) * (1.0f / DM) + 1e-6f);
#pragma unroll
        for (int j = 0; j < 8; ++j) { const f32x4 o = v[j] * r * gvv[j];
            if (OUT_F32) ((f32x4*)((float*)out + (size_t)m * DM))[64 * j + lane] = o;
            else { u32x2 w; w.x = pk2(o[0], o[1]); w.y = pk2(o[2], o[3]); ((u32x2*)((bf16_t*)out + (size_t)m * DM))[64 * j + lane] = w; } }
    }
}

constexpr int KP = 272, VP = 288, ATT_STAGE = 64 * KP + 64 * VP, ATT_X = 2 * ATT_STAGE;
static_assert(ATT_X + 65536 <= LDS_BYTES, "attention LDS");
#define MFMA32(a, b, c) __builtin_amdgcn_mfma_f32_32x32x16_bf16((a), (b), (c), 0, 0, 0)
typedef short v4i16_t __attribute__((ext_vector_type(4)));
DI s16x4 vtr(const LAS unsigned char* p) { return __builtin_bit_cast(s16x4, __builtin_amdgcn_ds_read_tr16_b64_v4i16((LAS v4i16_t*)p)); }

template <bool QK, bool PV>
DI void att_step(int t, LAS unsigned char* lds, const bf16_t* kg, const bf16_t* vg, int srow, int sch, int r, int h, int c, int voff0,
                 const bf16x8 (&qf)[4], f32x16 (&O)[4], bf16x8 (&pf)[4], float& mrun, float& lrun) {
    const LAS unsigned char* kbase = lds + (t & 1) * (64 * KP);
    const LAS unsigned char* vbase = lds + 2 * 64 * KP + ((t - 1) & 1) * (64 * VP);
    u32x4 kr[2], vr[2];
    const bool ldk = QK && (t + 1 < 64);
    if (ldk) {
#pragma unroll
        for (int i = 0; i < 2; ++i) kr[i] = *(const u32x4*)(kg + (size_t)((t + 1) * 64 + i * 32) * DATT);
    }
    if (QK) {
#pragma unroll
        for (int i = 0; i < 2; ++i) vr[i] = *(const u32x4*)(vg + (size_t)(t * 64 + i * 32) * DATT);
    }
    f32x16 S[2]; bf16x8 pfn[4]; s16x4 vA[4][2], vB[4][2];
#define VFRAG_LOAD(dstv, dt_) do { _Pragma("unroll") for (int kk_ = 0; kk_ < 4; ++kk_) { \
        const LAS unsigned char* vp_ = vbase + voff0 + (16 * kk_) * VP + 64 * (dt_); dstv[kk_][0] = vtr(vp_); dstv[kk_][1] = vtr(vp_ + 8 * VP); } } while (0)
#define PV_MMA(srcv, dt_) do { _Pragma("unroll") for (int kk_ = 0; kk_ < 4; ++kk_) { \
        const bf16x8 vf_ = __builtin_shufflevector(srcv[kk_][0], srcv[kk_][1], 0, 1, 2, 3, 4, 5, 6, 7); O[dt_] = MFMA32(vf_, pf[kk_], O[dt_]); } } while (0)
    if (QK) {
        bf16x8 kf[2][4];
#pragma unroll
        for (int kti = 0; kti < 2; ++kti)
#pragma unroll
            for (int ks = 0; ks < 4; ++ks) kf[kti][ks] = *(const LAS bf16x8*)(kbase + (32 * kti + r) * KP + c * 128 + (16 * ks + 8 * h) * 2);
        if (PV) VFRAG_LOAD(vA, 0);
        __builtin_amdgcn_sched_barrier(0);
#pragma unroll
        for (int kti = 0; kti < 2; ++kti)
#pragma unroll
            for (int ks = 0; ks < 4; ++ks) { if (ks == 0) { f32x16 z; _Pragma("unroll") for (int i = 0; i < 16; ++i) z[i] = 0.f; S[kti] = MFMA32(kf[kti][ks], qf[ks], z); } else S[kti] = MFMA32(kf[kti][ks], qf[ks], S[kti]); }
        float tm0 = fmaxf(fmaxf(S[0][0], S[0][1]), S[0][2]), tm1 = fmaxf(fmaxf(S[1][0], S[1][1]), S[1][2]);
#pragma unroll
        for (int i = 3; i < 15; i += 2) { tm0 = fmaxf(fmaxf(tm0, S[0][i]), S[0][i + 1]); tm1 = fmaxf(fmaxf(tm1, S[1][i]), S[1][i + 1]); }
        float tmax = fmaxf(fmaxf(tm0, tm1), fmaxf(S[0][15], S[1][15]));
        if (!PV || __builtin_amdgcn_ballot_w64(tmax > mrun + 8.0f) != 0ull) {
            tmax = fmaxf(tmax, __shfl_xor(tmax, 32));
            const float mnew = !PV ? tmax : fmaxf(tmax, mrun);
            const float alpha = !PV ? 1.0f : __builtin_amdgcn_exp2f(mrun - mnew);
            mrun = mnew; lrun *= alpha;
            if (PV) {
#pragma unroll
                for (int dt = 0; dt < 4; ++dt)
#pragma unroll
                    for (int i = 0; i < 16; ++i) O[dt][i] *= alpha;
#pragma unroll
                for (int kk = 0; kk < 4; ++kk) { u32x4 w = __builtin_bit_cast(u32x4, pf[kk]);
                    w.x = pk2(bflo(w.x) * alpha, bfhi(w.x) * alpha); w.y = pk2(bflo(w.y) * alpha, bfhi(w.y) * alpha); w.z = pk2(bflo(w.z) * alpha, bfhi(w.z) * alpha); w.w = pk2(bflo(w.w) * alpha, bfhi(w.w) * alpha);
                    pf[kk] = __builtin_bit_cast(bf16x8, w); }
            }
        }
        __builtin_amdgcn_sched_barrier(0);
    } else {
        VFRAG_LOAD(vA, 0);
    }
    if (PV) VFRAG_LOAD(vB, 1);
    if (QK) {
        f32x2_t ls2 = {0.f, 0.f};
#pragma unroll
        for (int kti = 0; kti < 2; ++kti)
#pragma unroll
            for (int i = 0; i < 16; i += 2) { f32x2_t p2; p2.x = __builtin_amdgcn_exp2f(S[kti][i] - mrun); p2.y = __builtin_amdgcn_exp2f(S[kti][i + 1] - mrun); S[kti][i] = p2.x; S[kti][i + 1] = p2.y; ls2 += p2; }
        lrun += ls2.x + ls2.y;
#pragma unroll
        for (int kk = 0; kk < 4; ++kk) { const int kti = kk >> 1, s = kk & 1; u32x4 w; w.x = pk2(S[kti][8 * s + 0], S[kti][8 * s + 1]); w.y = pk2(S[kti][8 * s + 2], S[kti][8 * s + 3]);
            w.z = pk2(S[kti][8 * s + 4], S[kti][8 * s + 5]); w.w = pk2(S[kti][8 * s + 6], S[kti][8 * s + 7]); pfn[kk] = __builtin_bit_cast(bf16x8, w); }
    }
    if (PV) {
        PV_MMA(vA, 0); VFRAG_LOAD(vA, 2); PV_MMA(vB, 1); VFRAG_LOAD(vB, 3); PV_MMA(vA, 2); PV_MMA(vB, 3);
    }
#ifdef ATT_INTERLEAVE
    if (QK && PV) {
        __builtin_amdgcn_sched_group_barrier(0x100, 8, 0);
#pragma unroll
        for (int gi = 0; gi < 16; ++gi) { __builtin_amdgcn_sched_group_barrier(0x008, 1, 0); __builtin_amdgcn_sched_group_barrier(0x402, 6, 0); if (gi == 1 || gi == 5) __builtin_amdgcn_sched_group_barrier(0x100, 8, 0); }
    }
#endif
    __builtin_amdgcn_sched_barrier(0);
    if (QK) {
#pragma unroll
        for (int kk = 0; kk < 4; ++kk) pf[kk] = pfn[kk];
        LAS unsigned char* nk = lds + ((t + 1) & 1) * (64 * KP); LAS unsigned char* nv = lds + 2 * 64 * KP + (t & 1) * (64 * VP);
        if (ldk) {
#pragma unroll
            for (int i = 0; i < 2; ++i) *(LAS u32x4*)(nk + (srow + 32 * i) * KP + sch * 16) = kr[i];
        }
#pragma unroll
        for (int i = 0; i < 2; ++i) *(LAS u32x4*)(nv + (srow + 32 * i) * VP + sch * 16) = vr[i];
    }
    __syncthreads();
#undef VFRAG_LOAD
#undef PV_MMA
}

DI void attn_phase(LAS unsigned char* lds, const bf16_t* Q, const bf16_t* K, const bf16_t* V, bf16_t* YB, const float* lamvec, const float* subln, float lambda_init, int vcu, int G) {
    int tid_ = threadIdx.x; asm volatile("" : "+v"(tid_));
    const int tid = tid_, lane = tid & 63, wave = __builtin_amdgcn_readfirstlane(tid >> 6), r = lane & 31, h = lane >> 5, qs = wave & 3, c = wave >> 2;
    const float lam = __expf(wave_sum(lamvec[lane] * lamvec[64 + lane])) - __expf(wave_sum(lamvec[128 + lane] * lamvec[192 + lane])) + lambda_init;
    const int srow = tid >> 4, sch = tid & 15;
    const int tq = (lane & 15) >> 2, tp = lane & 3, blk = (lane >> 4) & 1;
    for (int item = vcu; item < 512; item += G) {
        const int pair = item >> 5, qb = item & 31, b = pair >> 3, hd = pair & 7;
        const int rowq = b * SEQ + qb * 128 + qs * 32 + r;
        bf16x8 qf[4];
#pragma unroll
        for (int ks = 0; ks < 4; ++ks) qf[ks] = *(const bf16x8*)(Q + (size_t)rowq * DATT + hd * 128 + c * 64 + 16 * ks + 8 * h);
        f32x16 O[4];
#pragma unroll
        for (int dt = 0; dt < 4; ++dt)
#pragma unroll
            for (int i = 0; i < 16; ++i) O[dt][i] = 0.f;
        float mrun = 0.f, lrun = 0.f;
        const bf16_t* kg = K + (size_t)(b * SEQ + srow) * DATT + hd * 128 + sch * 8;
        const bf16_t* vg = V + (size_t)(b * SEQ + srow) * DATT + hd * 128 + sch * 8;
        u32x4 kr[2], vr[2];
#pragma unroll
        for (int i = 0; i < 2; ++i) kr[i] = *(const u32x4*)(kg + (size_t)(i * 32) * DATT);
#pragma unroll
        for (int i = 0; i < 2; ++i) *(LAS u32x4*)(lds + (srow + 32 * i) * KP + sch * 16) = kr[i];
        __syncthreads();
        bf16x8 pf[4];
#pragma unroll
        for (int i = 0; i < 4; ++i) pf[i] = (bf16x8){0, 0, 0, 0, 0, 0, 0, 0};
        const int voff0 = (4 * h + tq) * VP + (16 * blk) * 2 + 8 * tp;
        att_step<true, false>(0, lds, kg, vg, srow, sch, r, h, c, voff0, qf, O, pf, mrun, lrun);
        for (int t = 1; t < 64; ++t) att_step<true, true>(t, lds, kg, vg, srow, sch, r, h, c, voff0, qf, O, pf, mrun, lrun);
        att_step<false, true>(64, lds, kg, vg, srow, sch, r, h, c, voff0, qf, O, pf, mrun, lrun);
        const float ltot = lrun + __shfl_xor(lrun, 32), inv = 1.0f / ltot;
        LAS float* X = (LAS float*)(lds + ATT_X + qs * 16384);
        if (c == 1) { const float sc = lam * inv;
#pragma unroll
            for (int dt = 0; dt < 4; ++dt)
#pragma unroll
                for (int i = 0; i < 16; ++i) X[(dt * 16 + i) * 64 + lane] = O[dt][i] * sc; }
        __syncthreads();
        if (c == 0) {
            float ss = 0.f;
#pragma unroll
            for (int dt = 0; dt < 4; ++dt)
#pragma unroll
                for (int i = 0; i < 16; ++i) { const float o = O[dt][i] * inv - X[(dt * 16 + i) * 64 + lane]; O[dt][i] = o; ss += o * o; }
            ss += __shfl_xor(ss, 32);
            const float rn = (1.0f / sqrtf(ss * (1.0f / 128.0f) + 1e-6f)) * (1.0f - lambda_init);
            bf16_t* op = YB + (size_t)rowq * DATT + hd * 128;
#pragma unroll
            for (int dt = 0; dt < 4; ++dt)
#pragma unroll
                for (int g4 = 0; g4 < 4; ++g4) { const int d = 32 * dt + 8 * g4 + 4 * h; const f32x4 gv = *(const f32x4*)(subln + d);
                    u32x2 w; w.x = pk2(O[dt][4 * g4 + 0] * rn * gv[0], O[dt][4 * g4 + 1] * rn * gv[1]); w.y = pk2(O[dt][4 * g4 + 2] * rn * gv[2], O[dt][4 * g4 + 3] * rn * gv[3]);
                    *(u32x2*)(op + d) = w; }
        }
        __syncthreads();
    }
}

constexpr int S5_WAVE_LDS = 12800, S5_SP = 132;
struct S5Par { float ar, ai, cr, ci; };
DI S5Par s5_par(const float* lre, const float* lim, const float* ldt, int dir, int g, int n) {
    const float dt = expf(ldt[dir * 32 + g]), lr = lre[(dir * 32 + g) * 64 + n], li = lim[(dir * 32 + g) * 64 + n];
    const float mag = expf(dt * lr); S5Par p; p.ar = mag * cosf(dt * li); p.ai = mag * sinf(dt * li);
    const float den = lr * lr + li * li, nr = p.ar - 1.0f; p.cr = (nr * lr + p.ai * li) / den; p.ci = (p.ai * lr - nr * li) / den; return p;
}
DI void s5_load_u(LAS float* us, const float* U, int b, int g, int c, int lane) {
    const f32x4* up = (const f32x4*)(U + (size_t)(b * SEQ + c * 64 + lane) * DSSM + g * 16);
#pragma unroll
    for (int j = 0; j < 4; ++j) *(LAS f32x4*)(us + lane * 16 + 4 * j) = up[j];
    LDS_WAIT(); __builtin_amdgcn_wave_barrier();
}
DI void s5_bu(const LAS float* us, int t, const float (&Bre)[16], const float (&Bim)[16], float& bur, float& bui) {
    float r0 = 0.f, r1 = 0.f, i0 = 0.f, i1 = 0.f;
#pragma unroll
    for (int j = 0; j < 4; ++j) { const f32x4 u = *(const LAS f32x4*)(us + t * 16 + 4 * j);
        r0 += u[0] * Bre[4 * j + 0]; r1 += u[1] * Bre[4 * j + 1]; r0 += u[2] * Bre[4 * j + 2]; r1 += u[3] * Bre[4 * j + 3];
        i0 += u[0] * Bim[4 * j + 0]; i1 += u[1] * Bim[4 * j + 1]; i0 += u[2] * Bim[4 * j + 2]; i1 += u[3] * Bim[4 * j + 3]; }
    bur = r0 + r1; bui = i0 + i1;
}
struct URow { f32x4 v[4]; };
DI URow s5_ldu(const LAS float* us, int t) { URow u;
#pragma unroll
    for (int j = 0; j < 4; ++j) u.v[j] = *(const LAS f32x4*)(us + t * 16 + 4 * j);
    return u; }
DI void s5_bu_r(const URow& u, const float (&Bre)[16], const float (&Bim)[16], float& bur, float& bui) {
    float r0 = 0.f, r1 = 0.f, i0 = 0.f, i1 = 0.f;
#pragma unroll
    for (int j = 0; j < 4; ++j) {
        r0 += u.v[j][0] * Bre[4 * j + 0]; r1 += u.v[j][1] * Bre[4 * j + 1]; r0 += u.v[j][2] * Bre[4 * j + 2]; r1 += u.v[j][3] * Bre[4 * j + 3];
        i0 += u.v[j][0] * Bim[4 * j + 0]; i1 += u.v[j][1] * Bim[4 * j + 1]; i0 += u.v[j][2] * Bim[4 * j + 2]; i1 += u.v[j][3] * Bim[4 * j + 3]; }
    bur = r0 + r1; bui = i0 + i1;
}
DI void s5_pass1(LAS unsigned char* lds, const float* U, float* SE, const float* lre, const float* lim, const float* ldt, const float* bre, const float* bim, int gw, int NGW) {
    int tid_ = threadIdx.x; asm volatile("" : "+v"(tid_));
    const int lane = tid_ & 63, wave = __builtin_amdgcn_readfirstlane(tid_ >> 6);
    LAS float* us = (LAS float*)(lds + wave * S5_WAVE_LDS);
    for (int item = gw; item < 4096; item += NGW) {
        const int c = item & 63, bg = item >> 6, g = bg & 31, b = bg >> 5;
        const S5Par pf = s5_par(lre, lim, ldt, 0, g, lane), pb = s5_par(lre, lim, ldt, 1, g, lane);
        float Bre[16], Bim[16];
#pragma unroll
        for (int j = 0; j < 4; ++j) { const f32x4 a = *(const f32x4*)(bre + (size_t)(g * 64 + lane) * 16 + 4 * j), bb = *(const f32x4*)(bim + (size_t)(g * 64 + lane) * 16 + 4 * j);
#pragma unroll
            for (int e = 0; e < 4; ++e) { Bre[4 * j + e] = a[e]; Bim[4 * j + e] = bb[e]; } }
        s5_load_u(us, U, b, g, c, lane);
        float efr = 0.f, efi = 0.f, ebr = 0.f, ebi = 0.f, pwr = 1.f, pwi = 0.f;
#pragma unroll 4
        for (int t = 0; t < 64; ++t) {
            float bur, bui; s5_bu(us, t, Bre, Bim, bur, bui);
            const float fr_ = pf.cr * bur - pf.ci * bui, fi_ = pf.cr * bui + pf.ci * bur;
            const float nfr = pf.ar * efr - pf.ai * efi + fr_, nfi = pf.ar * efi + pf.ai * efr + fi_; efr = nfr; efi = nfi;
            const float br_ = pb.cr * bur - pb.ci * bui, bi_ = pb.cr * bui + pb.ci * bur;
            ebr += pwr * br_ - pwi * bi_; ebi += pwr * bi_ + pwi * br_;
            const float npr = pwr * pb.ar - pwi * pb.ai, npi = pwr * pb.ai + pwi * pb.ar; pwr = npr; pwi = npi;
        }
        float* se = SE + (size_t)item * 256 + lane; se[0] = efr; se[64] = efi; se[128] = ebr; se[192] = ebi;
        __builtin_amdgcn_wave_barrier();
    }
}
DI void s5_pass2(LAS unsigned char* lds, const float* U, const float* SE, bf16_t* YG, const float* lre, const float* lim, const float* ldt, const float* bre, const float* bim,
                 const float* cre, const float* cim, const float* dsk, int gw, int NGW) {
    int tid_ = threadIdx.x; asm volatile("" : "+v"(tid_));
    const int lane = tid_ & 63, wave = __builtin_amdgcn_readfirstlane(tid_ >> 6), l15 = lane & 15, l4 = lane >> 4;
    LAS float* us = (LAS float*)(lds + wave * S5_WAVE_LDS); LAS float* Ss = us + 1024;
    for (int item = gw; item < 4096; item += NGW) {
        const int c = item & 63, bg = item >> 6, g = bg & 31, b = bg >> 5;
        const S5Par pf = s5_par(lre, lim, ldt, 0, g, lane), pb = s5_par(lre, lim, ldt, 1, g, lane);
        float Bre[16], Bim[16], Cm[32];
#pragma unroll
        for (int j = 0; j < 4; ++j) { const f32x4 a = *(const f32x4*)(bre + (size_t)(g * 64 + lane) * 16 + 4 * j), bb = *(const f32x4*)(bim + (size_t)(g * 64 + lane) * 16 + 4 * j);
#pragma unroll
            for (int e = 0; e < 4; ++e) { Bre[4 * j + e] = a[e]; Bim[4 * j + e] = bb[e]; } }
#pragma unroll
        for (int m = 0; m < 16; ++m) { Cm[m] = cre[(size_t)(g * 16 + l15) * 64 + 4 * m + l4]; Cm[16 + m] = -cim[(size_t)(g * 16 + l15) * 64 + 4 * m + l4]; }
        s5_load_u(us, U, b, g, c, lane);
        float afr = pf.ar, afi = pf.ai, abr = pb.ar, abi = pb.ai;
#pragma unroll
        for (int i = 0; i < 6; ++i) { const float x = afr * afr - afi * afi, y = 2.f * afr * afi; afr = x; afi = y; const float z = abr * abr - abi * abi, w = 2.f * abr * abi; abr = z; abi = w; }
        float sfr = 0.f, sfi = 0.f, sbr = 0.f, sbi = 0.f;
        const float* seb = SE + (size_t)(bg * 64) * 256 + lane;
#pragma unroll 1
        for (int c8 = 0; c8 < 64; c8 += 8) {
            float er[8], ei[8], br[8], bi[8];
#pragma unroll
            for (int j = 0; j < 8; ++j) { er[j] = seb[(size_t)(c8 + j) * 256]; ei[j] = seb[(size_t)(c8 + j) * 256 + 64]; br[j] = seb[(size_t)(63 - c8 - j) * 256 + 128]; bi[j] = seb[(size_t)(63 - c8 - j) * 256 + 192]; }
#pragma unroll
            for (int j = 0; j < 8; ++j) {
                if (c8 + j < c) { const float x = afr * sfr - afi * sfi + er[j], y = afr * sfi + afi * sfr + ei[j]; sfr = x; sfi = y; }
                if (63 - c8 - j > c) { const float x = abr * sbr - abi * sbi + br[j], y = abr * sbi + abi * sbr + bi[j]; sbr = x; sbi = y; }
            }
        }
        f32x4 Y[4];
#pragma unroll
        for (int s = 0; s < 4; ++s) Y[s] = (f32x4){0.f, 0.f, 0.f, 0.f};
#pragma unroll
        for (int sub = 0; sub < 4; ++sub) {
            URow ucur = s5_ldu(us, 16 * sub);
#pragma unroll 4
            for (int tt = 0; tt < 16; ++tt) {
                const URow unxt = s5_ldu(us, (16 * sub + tt + 1) & 63);
                float bur, bui; s5_bu_r(ucur, Bre, Bim, bur, bui); ucur = unxt;
                const float fr_ = pf.cr * bur - pf.ci * bui, fi_ = pf.cr * bui + pf.ci * bur;
                const float x = pf.ar * sfr - pf.ai * sfi + fr_, y = pf.ar * sfi + pf.ai * sfr + fi_; sfr = x; sfi = y;
                Ss[tt * S5_SP + lane] = sfr; Ss[tt * S5_SP + 64 + lane] = sfi;
            }
            LDS_WAIT(); __builtin_amdgcn_wave_barrier();
#pragma unroll
            for (int m = 0; m < 32; ++m) { const float bv = Ss[l15 * S5_SP + 4 * m + l4]; Y[sub] = __builtin_amdgcn_mfma_f32_16x16x4f32(Cm[m], bv, Y[sub], 0, 0, 0); }
            LDS_WAIT(); __builtin_amdgcn_wave_barrier();
        }
#pragma unroll
        for (int sub = 3; sub >= 0; --sub) {
            URow ucur = s5_ldu(us, 16 * sub + 15);
#pragma unroll 4
            for (int tt = 15; tt >= 0; --tt) {
                const URow unxt = s5_ldu(us, (16 * sub + tt - 1) & 63);
                float bur, bui; s5_bu_r(ucur, Bre, Bim, bur, bui); ucur = unxt;
                const float br_ = pb.cr * bur - pb.ci * bui, bi_ = pb.cr * bui + pb.ci * bur;
                const float x = pb.ar * sbr - pb.ai * sbi + br_, y = pb.ar * sbi + pb.ai * sbr + bi_; sbr = x; sbi = y;
                Ss[tt * S5_SP + lane] = sbr; Ss[tt * S5_SP + 64 + lane] = sbi;
            }
            LDS_WAIT(); __builtin_amdgcn_wave_barrier();
#pragma unroll
            for (int m = 0; m < 32; ++m) { const float bv = Ss[l15 * S5_SP + 4 * m + l4]; Y[sub] = __builtin_amdgcn_mfma_f32_16x16x4f32(Cm[m], bv, Y[sub], 0, 0, 0); }
            LDS_WAIT(); __builtin_amdgcn_wave_barrier();
        }
        const f32x4 dv = *(const f32x4*)(dsk + g * 16 + 4 * l4);
#pragma unroll
        for (int sub = 0; sub < 4; ++sub) { const int t = 16 * sub + l15; const f32x4 uv = *(const LAS f32x4*)(us + t * 16 + 4 * l4);
            float y[4];
#pragma unroll
            for (int v = 0; v < 4; ++v) y[v] = gelu_tanh(Y[sub][v] + dv[v] * uv[v]);
            u32x2 w; w.x = pk2(y[0], y[1]); w.y = pk2(y[2], y[3]);
            *(u32x2*)(YG + (size_t)(b * SEQ + c * 64 + t) * DSSM + g * 16 + 4 * l4) = w; }
        LDS_WAIT(); __builtin_amdgcn_wave_barrier();
    }
}

DI void conv_phase(const bf16_t* BG, const bf16_t* CG, const bf16_t* XV, const float* cw, bf16_t* YC, int gt, int NT) {
    for (int idx = gt; idx < M * 64; idx += NT) {
        const int row = idx >> 6, ch = (idx & 63) * 8, t = row & (SEQ - 1);
        const size_t o = (size_t)row * DCONV + ch;
        const u32x4 zero = {0u, 0u, 0u, 0u};
        const u32x4 c1 = *(const u32x4*)(CG + o), x1 = *(const u32x4*)(XV + o), bgv = *(const u32x4*)(BG + o);
        const u32x4 c0 = t > 0 ? *(const u32x4*)(CG + o - DCONV) : zero, x0 = t > 0 ? *(const u32x4*)(XV + o - DCONV) : zero;
        const u32x4 c2 = t < SEQ - 1 ? *(const u32x4*)(CG + o + DCONV) : zero, x2 = t < SEQ - 1 ? *(const u32x4*)(XV + o + DCONV) : zero;
        float y[8];
#pragma unroll
        for (int j = 0; j < 4; ++j) {
            const float w0a = cw[ch + 2 * j], w0b = cw[ch + 2 * j + 1], w1a = cw[DCONV + ch + 2 * j], w1b = cw[DCONV + ch + 2 * j + 1], w2a = cw[2 * DCONV + ch + 2 * j], w2b = cw[2 * DCONV + ch + 2 * j + 1];
            y[2 * j] = bflo(bgv[j]) * (w0a * bflo(c0[j]) * bflo(x0[j]) + w1a * bflo(c1[j]) * bflo(x1[j]) + w2a * bflo(c2[j]) * bflo(x2[j]));
            y[2 * j + 1] = bfhi(bgv[j]) * (w0b * bfhi(c0[j]) * bfhi(x0[j]) + w1b * bfhi(c1[j]) * bfhi(x1[j]) + w2b * bfhi(c2[j]) * bfhi(x2[j]));
        }
        u32x4 w; w.x = pk2(y[0], y[1]); w.y = pk2(y[2], y[3]); w.z = pk2(y[4], y[5]); w.w = pk2(y[6], y[7]);
        *(u32x4*)(YC + o) = w;
    }
}

#define XB_TMO      128
#define XB_XCNT(j)  (256  + 64 * (j))
#define XB_XSUB(j)  (1280 + 64 * (j))
#define XB_XGEN(j)  (2304 + 64 * (j))
#define XB_TOP      3328
#define XB_TOPGEN   3392
#define XCD_BAR_WORDS 3456
#define XB_SPIN_CAP (1u << 18)
DI unsigned xb_ld(unsigned* p)              { return __hip_atomic_load(p, __ATOMIC_RELAXED, __HIP_MEMORY_SCOPE_AGENT); }
DI unsigned xb_add(unsigned* p, unsigned v) { return __hip_atomic_fetch_add(p, v, __ATOMIC_RELAXED, __HIP_MEMORY_SCOPE_AGENT); }
DI unsigned xb_xcc_id() { return (unsigned)__builtin_amdgcn_s_getreg((3 << 11) | 20) & 0xFu; }
#define XB_SPIN(cond, bar) do { unsigned _sp = 0; while (cond) { __builtin_amdgcn_s_sleep(1); \
    if ((++_sp & 255u) == 0u) { if (xb_ld(&(bar)[XB_TMO])) break; if (_sp > XB_SPIN_CAP) { atomicAdd(&(bar)[XB_TMO], 1u); break; } } } } while (0)
struct XcdBarrier { unsigned* bar; unsigned x; volatile LAS unsigned* st; };
DI XcdBarrier xcd_barrier_post(unsigned* bar, volatile LAS unsigned* st) {
    XcdBarrier b; b.bar = bar; b.x = xb_xcc_id(); b.st = st;
    if (threadIdx.x == 0) (void)xb_add(&bar[XB_XCNT(b.x)], 1u);
    return b;
}
DI void xcd_barrier_complete(unsigned* bar, unsigned x, unsigned& nloc, unsigned& nx) {
    const unsigned G = gridDim.x * gridDim.y * gridDim.z;
    unsigned sum, cnt, mine, sp = 0u;
    for (;;) {
        sum = 0u; cnt = 0u; mine = 0u;
#pragma unroll
        for (unsigned j = 0; j < 16; ++j) { const unsigned c = xb_ld(&bar[XB_XCNT(j)]); sum += c; cnt += (c > 0u) ? 1u : 0u; mine = (j == x) ? c : mine; }
        if (sum == G) break;
        __builtin_amdgcn_s_sleep(1);
        if ((++sp & 255u) == 0u) { if (xb_ld(&bar[XB_TMO])) break; if (sp > XB_SPIN_CAP) { atomicAdd(&bar[XB_TMO], 1u); break; } }
    }
    nloc = mine > 0u ? mine : 1u; nx = cnt > 0u ? cnt : 1u;
}
DI void xcd_barrier(const XcdBarrier& b) {
    asm volatile("s_waitcnt vmcnt(0)" ::: "memory");
    __syncthreads();
    if (threadIdx.x == 0) {
        unsigned* bar = b.bar;
        __builtin_amdgcn_s_waitcnt(0);
        unsigned nloc = b.st[0], nx = b.st[1];
        if (nloc == 0u) { xcd_barrier_complete(bar, b.x, nloc, nx); b.st[0] = nloc; b.st[1] = nx; }
        const unsigned old = xb_add(&bar[XB_XSUB(b.x)], 1u);
        const unsigned gen = old / nloc;
        if (old + 1u == (gen + 1u) * nloc) {
            __builtin_amdgcn_fence(__ATOMIC_RELEASE, "agent");
            asm volatile("s_waitcnt vmcnt(0)" ::: "memory");
            const unsigned og = xb_add(&bar[XB_TOP], 1u);
            const unsigned tg = og / nx;
            if (og + 1u == (tg + 1u) * nx) xb_add(&bar[XB_TOPGEN], 1u);
            else XB_SPIN(xb_ld(&bar[XB_TOPGEN]) == tg, bar);
            __builtin_amdgcn_fence(__ATOMIC_ACQUIRE, "agent");
            xb_add(&bar[XB_XGEN(b.x)], 1u);
            asm volatile("s_waitcnt vmcnt(0)" ::: "memory");
        } else {
            XB_SPIN(xb_ld(&bar[XB_XGEN(b.x)]) == gen, bar);
            __builtin_amdgcn_fence(__ATOMIC_ACQUIRE, "agent");
            asm volatile("s_waitcnt vmcnt(0)" ::: "memory");
        }
    }
    __syncthreads();
}

#ifndef REP_PREP
#define REP_PREP 1
#endif
#ifndef REP_NORM
#define REP_NORM 1
#endif
#ifndef REP_ATT
#define REP_ATT 1
#endif
#ifndef REP_S5
#define REP_S5 1
#endif
#ifndef REP_SYNC
#define REP_SYNC 1
#endif
#define GSYNC() do { for (int rs_ = 0; rs_ < REP_SYNC; ++rs_) xcd_barrier(xbar); } while (0)
struct Params { const float* in[23]; float* out; unsigned char* ws; };
template <int OFF> DI unsigned long long karg_u64() { unsigned long long v; auto ka = __builtin_amdgcn_kernarg_segment_ptr();
    asm volatile("s_load_dwordx2 %0, %1, %2\n\ts_waitcnt lgkmcnt(0)" : "=s"(v) : "s"(ka), "n"(OFF) : "memory"); return v; }
#define ARG_IN(i) ((const float*)(const __attribute__((address_space(1))) float*)karg_u64<8 * (i)>())
#define ARG_OUT() ((float*)(__attribute__((address_space(1))) float*)karg_u64<8 * 23>())
#define ARG_WS() ((unsigned char*)(__attribute__((address_space(1))) unsigned char*)karg_u64<8 * 24>())

__global__ void __launch_bounds__(512, 2) fwd_megakernel(Params p) {
    extern __shared__ __attribute__((aligned(16))) unsigned char lds_raw[];
    LAS unsigned char* lds = (LAS unsigned char*)lds_raw;
    cg::grid_group grid = cg::this_grid();
    const int G = gridDim.x, bid = blockIdx.x;
    if (threadIdx.x < 16) ((LAS unsigned*)(lds + LDS_MISC))[threadIdx.x] = 0u;
    if (bid == 0) { unsigned* bw = (unsigned*)(ARG_WS() + WS_BAR); for (int i = threadIdx.x; i < XCD_BAR_WORDS; i += 512) bw[i] = 0u; }
    __syncthreads();
#define IDS() int tidk = threadIdx.x; asm volatile("" : "+v"(tidk)); const int lane = tidk & 63, wave = __builtin_amdgcn_readfirstlane(tidk >> 6); \
    const int gw = bid * 8 + wave, NGW = G * 8, gt = bid * 512 + tidk, NT = G * 512; (void)lane; (void)gw; (void)NGW; (void)gt; (void)NT

    for (int rep_ = 0; rep_ < REP_PREP; ++rep_) {
        IDS(); unsigned char* ws = ARG_WS();
        LAS float* scr = (LAS float*)(lds + wave * 16384);
        { const float* w13 = ARG_IN(2); for (int i = 0; i < 4; ++i) conv_matrix(w13 + (size_t)i * DM * 2 * DFF, 2 * DFF, DM, 2 * DFF, (bf16_t*)(ws + WS_W13T + i * SZ_W13T), 1, gw, NGW, scr, lane); }
        { const float* w2 = ARG_IN(3); for (int i = 0; i < 4; ++i) conv_matrix(w2 + (size_t)i * DFF * DM, DM, DFF, DM, (bf16_t*)(ws + WS_W2T + i * SZ_W2T), 0, gw, NGW, scr, lane); }
        for (int l = 0; l < 2; ++l) {
            bf16_t* wc = (bf16_t*)(ws + WS_WCOMB + l * SZ_WCOMB);
            conv_matrix(ARG_IN(4) + (size_t)l * DM * DIN, DIN, DM, DIN, wc, 2, gw, NGW, scr, lane);
            conv_matrix(ARG_IN(19) + (size_t)l * DM * NGATE, NGATE, DM, NGATE, wc + (size_t)DIN * DM, 0, gw, NGW, scr, lane);
            conv_matrix(ARG_IN(13) + (size_t)l * DSSM * DSSM, DSSM, DSSM, DSSM, (bf16_t*)(ws + WS_WGLU + l * SZ_WGLU), 0, gw, NGW, scr, lane);
            bf16_t* wb = (bf16_t*)(ws + WS_WBR + l * SZ_WBR); const float* wbs = ARG_IN(18) + (size_t)l * DM * DM;
            conv_matrix(wbs, DM, DSSM, DM, wb, 0, gw, NGW, scr, lane);
            conv_matrix(wbs + (size_t)DSSM * DM, DM, DATT, DM, wb + (size_t)DM * DSSM, 0, gw, NGW, scr, lane);
            conv_matrix(wbs + (size_t)(DSSM + DATT) * DM, DM, DCONV, DM, wb + (size_t)DM * (DSSM + DATT), 0, gw, NGW, scr, lane);
            conv_matrix(ARG_IN(21) + (size_t)l * DM * DM, DM, DM, DM, (bf16_t*)(ws + WS_WOUT + l * SZ_WOUT), 0, gw, NGW, scr, lane);
        }
        float* COS = (float*)(ws + WS_ROPE); float* SIN = COS + SEQ * 32;
        for (int idx = gt; idx < SEQ * 32; idx += NT) { const int pos = idx >> 5, d = idx & 31; const float inv = powf(10000.0f, -(float)(2 * d) / 64.0f); const float ang = (float)pos * inv; COS[idx] = cosf(ang); SIN[idx] = sinf(ang); }
    }
    grid.sync();
    XcdBarrier xbar = xcd_barrier_post((unsigned*)(ARG_WS() + WS_BAR), (volatile LAS unsigned*)(lds + LDS_MISC));

    for (int l = 0; l < DEPTH; ++l) {
        for (int rep_ = 0; rep_ < REP_NORM; ++rep_) { IDS(); unsigned char* ws = ARG_WS(); const float* xsrc = (l == 0) ? ARG_IN(0) : (const float*)(ws + WS_X);
          norm_rows<false>(xsrc, ARG_IN(1) + (size_t)(l * 3 + 0) * DM, ws + WS_H, gw, NGW, lane); }
        GSYNC();
        { unsigned char* ws = ARG_WS(); pg8::Gemm g{(const bf16_t*)(ws + WS_H), (const bf16_t*)(ws + WS_W13T + (size_t)(l * 2 + 0) * SZ_W13T), M, 2 * DFF, DM}; pg8::StaticOrder S; S.init(M, 2 * DFF, G, bid);
          pg8::EpiSwiglu E{(bf16_t*)(ws + WS_ACT)}; pg8::gemm_phase(lds, g, S, E); }
        GSYNC();
        { unsigned char* ws = ARG_WS(); const float* xsrc = (l == 0) ? ARG_IN(0) : (const float*)(ws + WS_X);
          pg8::Gemm g{(const bf16_t*)(ws + WS_ACT), (const bf16_t*)(ws + WS_W2T + (size_t)(l * 2 + 0) * SZ_W2T), M, DM, DFF}; pg8::StaticOrder S; S.init(M, DM, G, bid);
          pg8::EpiResid E{xsrc, (float*)(ws + WS_X), 0.5f}; pg8::gemm_phase(lds, g, S, E); }
        GSYNC();
        for (int rep_ = 0; rep_ < REP_NORM; ++rep_) { IDS(); unsigned char* ws = ARG_WS(); norm_rows<false>((const float*)(ws + WS_X), ARG_IN(1) + (size_t)(l * 3 + 1) * DM, ws + WS_H, gw, NGW, lane); }
        GSYNC();
        { unsigned char* ws = ARG_WS(); pg8::Gemm g{(const bf16_t*)(ws + WS_H), (const bf16_t*)(ws + WS_WCOMB + (size_t)l * SZ_WCOMB), M, NCOMB, DM}; pg8::StaticOrder S; S.init(M, NCOMB, G, bid);
          pg8::EpiInGate E{ws, ARG_IN(20) + (size_t)l * NGATE};
          pg8::gemm_phase(lds, g, S, E); }
        GSYNC();
        for (int rep_ = 0; rep_ < REP_S5; ++rep_) { IDS(); unsigned char* ws = ARG_WS();
          s5_pass1(lds, (const float*)(ws + WS_U), (float*)(ws + WS_SE), ARG_IN(5) + (size_t)l * 4096, ARG_IN(6) + (size_t)l * 4096, ARG_IN(7) + (size_t)l * 64,
                   ARG_IN(8) + (size_t)l * 32768, ARG_IN(9) + (size_t)l * 32768, gw, NGW);
          conv_phase((const bf16_t*)(ws + WS_BG), (const bf16_t*)(ws + WS_CG), (const bf16_t*)(ws + WS_XV), ARG_IN(17) + (size_t)l * 3 * DCONV, (bf16_t*)(ws + WS_YC), gt, NT); }
        GSYNC();
        for (int rep_ = 0; rep_ < REP_ATT; ++rep_) { unsigned char* ws = ARG_WS(); const float lambda_init = 0.8f - 0.6f * expf(-0.3f * (float)l);
          const int vcu = (G % 8 == 0) ? (bid % 8) * (G / 8) + bid / 8 : bid;
          attn_phase(lds, (const bf16_t*)(ws + WS_Q), (const bf16_t*)(ws + WS_K), (const bf16_t*)(ws + WS_V), (bf16_t*)(ws + WS_YB), ARG_IN(15) + (size_t)l * 256, ARG_IN(16) + (size_t)l * 128, lambda_init, vcu, G); }
        for (int rep_ = 0; rep_ < REP_S5; ++rep_) { IDS(); unsigned char* ws = ARG_WS();
          s5_pass2(lds, (const float*)(ws + WS_U), (const float*)(ws + WS_SE), (bf16_t*)(ws + WS_YG), ARG_IN(5) + (size_t)l * 4096, ARG_IN(6) + (size_t)l * 4096, ARG_IN(7) + (size_t)l * 64,
                   ARG_IN(8) + (size_t)l * 32768, ARG_IN(9) + (size_t)l * 32768, ARG_IN(10) + (size_t)l * 32768, ARG_IN(11) + (size_t)l * 32768, ARG_IN(12) + (size_t)l * DSSM, gw, NGW); }
        GSYNC();
        { unsigned char* ws = ARG_WS(); pg8::Gemm g{(const bf16_t*)(ws + WS_YG), (const bf16_t*)(ws + WS_WGLU + (size_t)l * SZ_WGLU), M, DSSM, DSSM}; pg8::StaticOrder S; S.init(M, DSSM, G, bid);
          pg8::EpiGLU E{(const bf16_t*)(ws + WS_YG), (bf16_t*)(ws + WS_YA), ARG_IN(14) + (size_t)l * DSSM}; pg8::gemm_phase(lds, g, S, E); }
        GSYNC();
        { unsigned char* ws = ARG_WS(); const bf16_t* wb = (const bf16_t*)(ws + WS_WBR + (size_t)l * SZ_WBR); pg8::StaticOrder S; S.init(M, DM, G, bid);
          pg8::Gemm g{(const bf16_t*)(ws + WS_YA), wb, M, DM, DSSM}; pg8::EpiBranch<0> E{(const bf16_t*)(ws + WS_GATE), (float*)(ws + WS_MF), (bf16_t*)(ws + WS_MB)}; pg8::gemm_phase(lds, g, S, E); }
        { unsigned char* ws = ARG_WS(); const bf16_t* wb = (const bf16_t*)(ws + WS_WBR + (size_t)l * SZ_WBR); pg8::StaticOrder S; S.init(M, DM, G, bid);
          pg8::Gemm g{(const bf16_t*)(ws + WS_YB), wb + (size_t)DM * DSSM, M, DM, DATT}; pg8::EpiBranch<1> E{(const bf16_t*)(ws + WS_GATE), (float*)(ws + WS_MF), (bf16_t*)(ws + WS_MB)}; pg8::gemm_phase(lds, g, S, E); }
        { unsigned char* ws = ARG_WS(); const bf16_t* wb = (const bf16_t*)(ws + WS_WBR + (size_t)l * SZ_WBR); pg8::StaticOrder S; S.init(M, DM, G, bid);
          pg8::Gemm g{(const bf16_t*)(ws + WS_YC), wb + (size_t)DM * (DSSM + DATT), M, DM, DCONV}; pg8::EpiBranch<2> E{(const bf16_t*)(ws + WS_GATE), (float*)(ws + WS_MF), (bf16_t*)(ws + WS_MB)}; pg8::gemm_phase(lds, g, S, E); }
        GSYNC();
        { unsigned char* ws = ARG_WS(); pg8::Gemm g{(const bf16_t*)(ws + WS_MB), (const bf16_t*)(ws + WS_WOUT + (size_t)l * SZ_WOUT), M, DM, DM}; pg8::StaticOrder S; S.init(M, DM, G, bid);
          pg8::EpiResid E{(const float*)(ws + WS_X), (float*)(ws + WS_X), 1.0f}; pg8::gemm_phase(lds, g, S, E); }
        GSYNC();
        for (int rep_ = 0; rep_ < REP_NORM; ++rep_) { IDS(); unsigned char* ws = ARG_WS(); norm_rows<false>((const float*)(ws + WS_X), ARG_IN(1) + (size_t)(l * 3 + 2) * DM, ws + WS_H, gw, NGW, lane); }
        GSYNC();
        { unsigned char* ws = ARG_WS(); pg8::Gemm g{(const bf16_t*)(ws + WS_H), (const bf16_t*)(ws + WS_W13T + (size_t)(l * 2 + 1) * SZ_W13T), M, 2 * DFF, DM}; pg8::StaticOrder S; S.init(M, 2 * DFF, G, bid);
          pg8::EpiSwiglu E{(bf16_t*)(ws + WS_ACT)}; pg8::gemm_phase(lds, g, S, E); }
        GSYNC();
        { unsigned char* ws = ARG_WS(); pg8::Gemm g{(const bf16_t*)(ws + WS_ACT), (const bf16_t*)(ws + WS_W2T + (size_t)(l * 2 + 1) * SZ_W2T), M, DM, DFF}; pg8::StaticOrder S; S.init(M, DM, G, bid);
          pg8::EpiResid E{(const float*)(ws + WS_X), (float*)(ws + WS_X), 0.5f}; pg8::gemm_phase(lds, g, S, E); }
        GSYNC();
    }
    for (int rep_ = 0; rep_ < REP_NORM; ++rep_) { IDS(); unsigned char* ws = ARG_WS(); norm_rows<true>((const float*)(ws + WS_X), ARG_IN(22), ARG_OUT(), gw, NGW, lane); }
}

extern "C" void kernel_launch(void* const* d_in, const int* in_sizes, int n_in, void* d_out, int out_size, void* d_ws, size_t ws_size, hipStream_t stream) {
    static int grid_blocks = 0;
    if (!grid_blocks) {
        if (n_in != 23 || out_size != M * DM || ws_size < WS_END) { fprintf(stderr, "kernel_launch: unexpected problem (n_in %d out %d ws %zu need %zu)\n", n_in, out_size, ws_size, (size_t)WS_END); grid_blocks = -1; return; }
        int dev = 0, cus = 0, per_cu = 0;
        (void)hipGetDevice(&dev);
        (void)hipDeviceGetAttribute(&cus, hipDeviceAttributeMultiprocessorCount, dev);
        (void)hipFuncSetAttribute((const void*)fwd_megakernel, hipFuncAttributeMaxDynamicSharedMemorySize, LDS_BYTES);
        (void)hipOccupancyMaxActiveBlocksPerMultiprocessor(&per_cu, (const void*)fwd_megakernel, 512, LDS_BYTES);
        if (per_cu < 1) per_cu = 1;
        grid_blocks = cus * per_cu;
    }
    if (grid_blocks < 0) return;
    Params p{};
    for (int i = 0; i < 23; ++i) p.in[i] = (const float*)d_in[i];
    p.out = (float*)d_out; p.ws = (unsigned char*)d_ws;
    void* args[] = {&p};
    hipError_t e = hipLaunchCooperativeKernel((void*)fwd_megakernel, dim3(grid_blocks), dim3(512), args, LDS_BYTES, stream);
    if (e != hipSuccess) fprintf(stderr, "cooperative launch failed: %s (grid %d)\n", hipGetErrorString(e), grid_blocks);
}
```

```cpp
#include <hip/hip_runtime.h>
#include <hip/hip_cooperative_groups.h>
#include <cstdio>
#include <cmath>
namespace cg = cooperative_groups;

#define LAS __attribute__((address_space(3)))
#define DI __device__ __forceinline__
typedef unsigned short bf16_t;
typedef short bf16x8 __attribute__((ext_vector_type(8)));
typedef short s16x4 __attribute__((ext_vector_type(4)));
typedef float f32x4 __attribute__((ext_vector_type(4)));
typedef float f32x16 __attribute__((ext_vector_type(16)));
typedef unsigned u32x4 __attribute__((ext_vector_type(4)));
typedef unsigned u32x2 __attribute__((ext_vector_type(2)));

constexpr int SEQ = 4096, M = 8192, DM = 2048, DFF = 5504, DSSM = 512, DATT = 1024, DCONV = 512, DIN = 5120, NGATE = 6144, NCOMB = DIN + NGATE, DEPTH = 2;
constexpr int LDS_BYTES = 147456, LDS_MISC = 147456 - 64;
constexpr float C2 = 0.125f * 1.4426950408889634f;

constexpr size_t al256(size_t x) { return (x + 255) & ~(size_t)255; }
constexpr size_t SZ_W13T = (size_t)2 * DFF * DM * 2, SZ_W2T = (size_t)DM * DFF * 2, SZ_WCOMB = (size_t)NCOMB * DM * 2, SZ_WGLU = (size_t)DSSM * DSSM * 2;
constexpr size_t SZ_WBR = (size_t)DM * DM * 2, SZ_WOUT = (size_t)DM * DM * 2;
constexpr size_t WS_W13T = 0;
constexpr size_t WS_W2T = WS_W13T + 4 * SZ_W13T;
constexpr size_t WS_WCOMB = WS_W2T + 4 * SZ_W2T;
constexpr size_t WS_WGLU = WS_WCOMB + 2 * SZ_WCOMB;
constexpr size_t WS_WBR = WS_WGLU + 2 * SZ_WGLU;
constexpr size_t WS_WOUT = WS_WBR + 2 * SZ_WBR;
constexpr size_t WS_ROPE = WS_WOUT + 2 * SZ_WOUT;
constexpr size_t WS_X = WS_ROPE + (size_t)2 * SEQ * 32 * 4;
constexpr size_t WS_H = WS_X + (size_t)M * DM * 4;
constexpr size_t WS_ACT = WS_H + (size_t)M * DM * 2;
constexpr size_t WS_U = WS_ACT + (size_t)M * DFF * 2;
constexpr size_t WS_Q = WS_U + (size_t)M * DSSM * 4;
constexpr size_t WS_K = WS_Q + (size_t)M * DATT * 2;
constexpr size_t WS_V = WS_K + (size_t)M * DATT * 2;
constexpr size_t WS_BG = WS_V + (size_t)M * DATT * 2;
constexpr size_t WS_CG = WS_BG + (size_t)M * DCONV * 2;
constexpr size_t WS_XV = WS_CG + (size_t)M * DCONV * 2;
constexpr size_t WS_GATE = WS_XV + (size_t)M * DCONV * 2;
constexpr size_t WS_YG = WS_GATE + (size_t)M * NGATE * 2;
constexpr size_t WS_YA = WS_YG + (size_t)M * DSSM * 2;
constexpr size_t WS_YB = WS_YA + (size_t)M * DSSM * 2;
constexpr size_t WS_YC = WS_YB + (size_t)M * DATT * 2;
constexpr size_t WS_MF = WS_YC + (size_t)M * DCONV * 2;
constexpr size_t WS_MB = WS_MF + (size_t)M * DM * 4;
constexpr size_t WS_SE = WS_MB + (size_t)M * DM * 2;
constexpr size_t WS_BAR = WS_SE + (size_t)4096 * 256 * 4;
constexpr size_t WS_END = WS_BAR + 16384;

typedef float f32x2_t __attribute__((ext_vector_type(2))); typedef __bf16 bf16x2_t __attribute__((ext_vector_type(2)));
DI unsigned pk2(float lo, float hi) { f32x2_t v = {lo, hi}; bf16x2_t b = __builtin_convertvector(v, bf16x2_t); return __builtin_bit_cast(unsigned, b); }
DI float bflo(unsigned w) { return __uint_as_float(w << 16); }
DI float bfhi(unsigned w) { return __uint_as_float(w & 0xffff0000u); }
DI float wave_sum(float v) {
#pragma unroll
    for (int o = 1; o < 64; o <<= 1) v += __shfl_xor(v, o);
    return v;
}
DI float sigmoidf_(float x) { return __builtin_amdgcn_rcpf(1.0f + __builtin_amdgcn_exp2f(-1.4426950408889634f * x)); }
DI float siluf_(float x) { return x * sigmoidf_(x); }
DI float gelu_tanh(float y) { const float z = 0.7978845608028654f * (y + 0.044715f * y * y * y); const float t = 1.0f - 2.0f / (1.0f + __expf(2.0f * z)); return 0.5f * y * (1.0f + t); }
#define LDS_WAIT() asm volatile("s_waitcnt lgkmcnt(0)" ::: "memory")

namespace pg8 {
constexpr int BM = 256, BK = 64, HALF = 128, HTB = HALF * BK * 2, STAGE_BYTES = 8 * HTB, NXCD = 8, WGM = 8;
DI int lds_byte(int r, int c) { const int st = (r >> 4) * 2 + (c >> 5), rr = r & 15, cc = c & 31, ob = rr * 64 + cc * 2; return st * 1024 + (ob ^ (((ob >> 9) & 1) << 5)); }
DI void stage_rc(int b, int& R, int& C) { const int st = b / 1024, sb = b % 1024, swz = sb ^ (((sb >> 9) & 1) << 5); R = (st >> 1) * 16 + swz / 64; C = (st & 1) * 32 + (swz % 64) / 2; }
DI int perm32(int rho) { const int n = rho >> 4, i = rho & 15; return 8 * (i >> 2) + 4 * n + (i & 3); }
struct Unit { int pm, pn; };
struct Gemm { const bf16_t* A; const bf16_t* Bt; int M, N, K; };
struct StaticOrder {
    int nM, nN, nwg, G, c;
    DI void init(int M_, int N_, int G_, int c_) { nM = M_ / BM; nN = N_ / BM; nwg = nM * nN; G = G_; c = c_; }
    DI bool next(int i, Unit& u) const {
        const long L = (long)i * G + c; if (L >= nwg) return false;
        int wgid = (int)L; { const int q = nwg / NXCD, r = nwg % NXCD, xcd = wgid % NXCD, off = wgid / NXCD; wgid = (xcd < r ? xcd * (q + 1) : r * (q + 1) + (xcd - r) * q) + off; }
        const int nig = WGM * nN, gid = wgid / nig, fm = gid * WGM, gsz = (nM - fm) < WGM ? (nM - fm) : WGM;
        u.pm = fm + ((wgid % nig) % gsz); u.pn = (wgid % nig) / gsz; return true;
    }
};
template <class Epi, bool ALIGN_EPI = true, bool SP2 = true>
DI void gemm_phase(LAS unsigned char* lds, const Gemm g, const StaticOrder& S, const Epi& E) {
    int tid_ = threadIdx.x; asm volatile("" : "+v"(tid_));
    const int tid = tid_, wid = __builtin_amdgcn_readfirstlane(tid >> 6), lane = tid & 63, wr = wid >> 2, wc = wid & 3, fr = lane & 15, fq = lane >> 4;
    const int K = g.K, nt = K / BK;
    unsigned voffA[2], voffB[2];
#pragma unroll
    for (int i = 0; i < 2; ++i) { int R, C; stage_rc(tid * 16 + i * 8192, R, C); const int Rb = Epi::PERM ? ((R & ~31) + perm32(R & 31)) : R;
        voffA[i] = (unsigned)(R * K + C) * 2u; voffB[i] = (unsigned)(Rb * K + C) * 2u; }
    const size_t kstep = (size_t)(BK * 2);
    const size_t hstep = (size_t)HALF * K * 2;
    const size_t tstep = 2 * hstep;
    const unsigned ldsw = (unsigned)wid * 1024u;
    const int aoff = lds_byte(wr * 64 + fr, fq * 8), boff = lds_byte(wc * 32 + fr, fq * 8);
#define PG8_SA(b, h) (((b) * 2 + (h)) * HTB)
#define PG8_SB(b, h) ((4 + (b) * 2 + (h)) * HTB)
#define PG8_STAGE(bufoff, gbase, voff) do { _Pragma("unroll") for (int _i = 0; _i < 2; ++_i) \
        __builtin_amdgcn_global_load_lds((const unsigned*)((const char*)(gbase) + (voff)[_i]), (LAS unsigned*)(lds + (bufoff) + ldsw + _i * 8192), 16, 0, 0); } while (0)
#define PG8_LDA(dst, b, h) do { _Pragma("unroll") for (int m = 0; m < 4; ++m) _Pragma("unroll") for (int k = 0; k < 2; ++k) dst[m][k] = *(const LAS bf16x8*)(lds + PG8_SA(b, h) + aoff + m * 2048 + k * 1024); } while (0)
#define PG8_LDB(dst, b, h) do { _Pragma("unroll") for (int n = 0; n < 2; ++n) _Pragma("unroll") for (int k = 0; k < 2; ++k) dst[n][k] = *(const LAS bf16x8*)(lds + PG8_SB(b, h) + boff + n * 2048 + k * 1024); } while (0)
#define PG8_MMA(ai, bj, At, Bt) do { __builtin_amdgcn_s_setprio(1); _Pragma("unroll") for (int m = 0; m < 4; ++m) _Pragma("unroll") for (int n = 0; n < 2; ++n) _Pragma("unroll") for (int k = 0; k < 2; ++k) \
        acc[ai][bj][m][n] = __builtin_amdgcn_mfma_f32_16x16x32_bf16(Bt[n][k], At[m][k], acc[ai][bj][m][n], 0, 0, 0); __builtin_amdgcn_s_setprio(0); } while (0)
#define PG8_WAIT_V(n) asm volatile("s_waitcnt vmcnt(" #n ")" ::: "memory")
#define PG8_WAIT_L(n) asm volatile("s_waitcnt lgkmcnt(" #n ")" ::: "memory")
#define PG8_BAR __builtin_amdgcn_s_barrier()
#define PG8_SCHED __builtin_amdgcn_sched_barrier(0)
    Unit cur, nxt; int ui = 0;
    if (!S.next(0, cur)) return;
    f32x4 acc[2][2][4][2];
#pragma unroll
    for (int a = 0; a < 2; ++a)
#pragma unroll
        for (int b = 0; b < 2; ++b)
#pragma unroll
            for (int m = 0; m < 4; ++m)
#pragma unroll
                for (int n = 0; n < 2; ++n) acc[a][b][m][n] = (f32x4){0.f, 0.f, 0.f, 0.f};
    bf16x8 At[4][2], B0[2][2], B1[2][2];
    const char* cA = (const char*)g.A + (size_t)cur.pm * tstep; const char* cB = (const char*)g.Bt + (size_t)cur.pn * tstep;
    if constexpr (SP2) {
        PG8_STAGE(PG8_SB(0, 0), cB, voffB); PG8_STAGE(PG8_SB(0, 1), cB + hstep, voffB); PG8_STAGE(PG8_SA(0, 0), cA, voffA); PG8_STAGE(PG8_SA(0, 1), cA + hstep, voffA);
        if (wr == 1) PG8_BAR;
        PG8_WAIT_V(2); PG8_BAR;
        PG8_STAGE(PG8_SB(1, 0), cB + kstep, voffB); PG8_STAGE(PG8_SA(1, 0), cA + kstep, voffA); PG8_STAGE(PG8_SB(1, 1), cB + hstep + kstep, voffB);
        PG8_WAIT_V(6); PG8_BAR;
    } else {
        PG8_STAGE(PG8_SB(0, 0), cB, voffB); PG8_STAGE(PG8_SA(0, 0), cA, voffA); PG8_STAGE(PG8_SB(0, 1), cB + hstep, voffB); PG8_STAGE(PG8_SA(0, 1), cA + hstep, voffA);
        if (wr == 1) PG8_BAR;
        PG8_WAIT_V(4); PG8_BAR;
        PG8_STAGE(PG8_SB(1, 0), cB + kstep, voffB); PG8_STAGE(PG8_SA(1, 0), cA + kstep, voffA); PG8_STAGE(PG8_SB(1, 1), cB + hstep + kstep, voffB);
        PG8_WAIT_V(6); PG8_BAR;
    }
    for (;;) {
        const bool has_next = S.next(ui + 1, nxt);
        const char* nA = has_next ? (const char*)g.A + (size_t)nxt.pm * tstep : cA; const char* nB = has_next ? (const char*)g.Bt + (size_t)nxt.pn * tstep : cB;
        for (int t = 0; t < nt; t += 2) {
            const bool last = (t == nt - 2);
            const char* a1 = cA + (size_t)(t + 1) * kstep;
            const char* a2 = last ? nA : cA + (size_t)(t + 2) * kstep; const char* b2 = last ? nB : cB + (size_t)(t + 2) * kstep;
            const char* a3 = a2 + kstep; const char* b3 = b2 + kstep;
            if constexpr (SP2) {
            PG8_LDB(B0, 0, 0); PG8_LDB(B1, 0, 1); PG8_SCHED; PG8_LDA(At, 0, 0); PG8_STAGE(PG8_SA(1, 1), a1 + hstep, voffA);
            PG8_WAIT_V(8); PG8_WAIT_L(0); PG8_BAR; PG8_MMA(0, 0, At, B0); PG8_MMA(0, 1, At, B1); PG8_BAR; PG8_SCHED;
            PG8_LDA(At, 0, 1); PG8_STAGE(PG8_SB(0, 0), b2, voffB); PG8_STAGE(PG8_SB(0, 1), b2 + hstep, voffB); PG8_STAGE(PG8_SA(0, 0), a2, voffA);
            PG8_WAIT_V(8); PG8_WAIT_L(0); PG8_BAR; PG8_MMA(1, 0, At, B0); PG8_MMA(1, 1, At, B1); PG8_BAR; PG8_SCHED;
            PG8_LDB(B0, 1, 0); PG8_LDB(B1, 1, 1); PG8_SCHED; PG8_LDA(At, 1, 0); PG8_STAGE(PG8_SA(0, 1), a2 + hstep, voffA);
            PG8_WAIT_V(8); PG8_WAIT_L(0); PG8_BAR; PG8_MMA(0, 0, At, B0); PG8_MMA(0, 1, At, B1); PG8_BAR; PG8_SCHED;
            PG8_LDA(At, 1, 1); PG8_STAGE(PG8_SB(1, 0), b3, voffB); PG8_STAGE(PG8_SB(1, 1), b3 + hstep, voffB); PG8_STAGE(PG8_SA(1, 0), a3, voffA);
            PG8_WAIT_V(8); PG8_WAIT_L(0); PG8_BAR; PG8_MMA(1, 0, At, B0); PG8_MMA(1, 1, At, B1); PG8_BAR; PG8_SCHED;
            } else {
            PG8_LDB(B0, 0, 0); PG8_SCHED; PG8_LDA(At, 0, 0); PG8_STAGE(PG8_SA(1, 1), a1 + hstep, voffA);
            PG8_WAIT_L(8); PG8_BAR; PG8_WAIT_L(0); PG8_MMA(0, 0, At, B0); PG8_BAR; PG8_SCHED;
            PG8_LDB(B1, 0, 1); PG8_STAGE(PG8_SB(0, 0), b2, voffB);
            PG8_BAR; PG8_WAIT_L(0); PG8_MMA(0, 1, At, B1); PG8_BAR;
            PG8_LDA(At, 0, 1); PG8_STAGE(PG8_SA(0, 0), a2, voffA);
            PG8_BAR; PG8_WAIT_L(0); PG8_MMA(1, 0, At, B0); PG8_BAR; PG8_SCHED;
            PG8_STAGE(PG8_SB(0, 1), b2 + hstep, voffB);
            PG8_WAIT_V(6); PG8_BAR; PG8_MMA(1, 1, At, B1); PG8_BAR;
            PG8_LDB(B0, 1, 0); PG8_SCHED; PG8_LDA(At, 1, 0); PG8_STAGE(PG8_SA(0, 1), a2 + hstep, voffA);
            PG8_WAIT_L(8); PG8_BAR; PG8_WAIT_L(0); PG8_MMA(0, 0, At, B0); PG8_BAR; PG8_SCHED;
            PG8_LDB(B1, 1, 1); PG8_STAGE(PG8_SB(1, 0), b3, voffB);
            PG8_BAR; PG8_WAIT_L(0); PG8_MMA(0, 1, At, B1); PG8_BAR;
            PG8_LDA(At, 1, 1); PG8_STAGE(PG8_SA(1, 0), a3, voffA);
            PG8_BAR; PG8_WAIT_L(0); PG8_MMA(1, 0, At, B0); PG8_BAR; PG8_SCHED;
            PG8_STAGE(PG8_SB(1, 1), b3 + hstep, voffB);
            PG8_WAIT_V(6); PG8_BAR; PG8_MMA(1, 1, At, B1); PG8_BAR;
            }
        }
        if constexpr (ALIGN_EPI) { if (wr == 0) PG8_BAR; }
        E(acc, cur, wr, wc, fr, fq);
        if (!has_next) break;
#pragma unroll
        for (int a = 0; a < 2; ++a)
#pragma unroll
            for (int b = 0; b < 2; ++b)
#pragma unroll
                for (int m = 0; m < 4; ++m)
#pragma unroll
                    for (int n = 0; n < 2; ++n) acc[a][b][m][n] = (f32x4){0.f, 0.f, 0.f, 0.f};
        cur = nxt; cA = nA; cB = nB; ++ui;
        if constexpr (ALIGN_EPI) { if (wr == 1) PG8_BAR; }
    }
    PG8_WAIT_V(0);
    if constexpr (!ALIGN_EPI) { if (wr == 0) PG8_BAR; }
    PG8_BAR;
#undef PG8_SA
#undef PG8_SB
#undef PG8_STAGE
#undef PG8_LDA
#undef PG8_LDB
#undef PG8_MMA
#undef PG8_WAIT_V
#undef PG8_WAIT_L
#undef PG8_BAR
#undef PG8_SCHED
}
typedef f32x4 Acc[2][2][4][2];

struct EpiSwiglu {
    static constexpr bool PERM = true; bf16_t* O;
    DI void operator()(const Acc& acc, const Unit& u, int wr, int wc, int fr, int fq) const {
        const int row0 = u.pm * BM + wr * 64 + fr, col0 = u.pn * 128 + wc * 32 + 8 * fq;
#pragma unroll
        for (int ai = 0; ai < 2; ++ai)
#pragma unroll
            for (int m = 0; m < 4; ++m) {
                bf16_t* rowp = O + (size_t)(row0 + ai * HALF + m * 16) * DFF + col0;
                const f32x4 a0 = acc[ai][0][m][0], a1 = acc[ai][0][m][1], b0 = acc[ai][1][m][0], b1 = acc[ai][1][m][1];
                float v[8];
#pragma unroll
                for (int e = 0; e < 4; ++e) { v[e] = siluf_(a0[e]) * b0[e]; v[4 + e] = siluf_(a1[e]) * b1[e]; }
                u32x4 w; w.x = pk2(v[0], v[1]); w.y = pk2(v[2], v[3]); w.z = pk2(v[4], v[5]); w.w = pk2(v[6], v[7]);
                *(u32x4*)rowp = w;
            }
    }
};
template <bool SRC_F32> struct EpiResid {
    static constexpr bool PERM = true; const void* src; bf16_t* dst; float scale;
    struct Grp { f32x4 f[4]; u32x4 h[2]; };
    DI void operator()(const Acc& acc, const Unit& u, int wr, int wc, int fr, int fq) const {
        const int row0 = u.pm * BM + wr * 64 + fr, col0 = u.pn * BM + wc * 32 + 8 * fq;
        Grp cur, nxt;
#define ER_LOAD(dstv, g) do { const size_t off_ = (size_t)(row0 + ((g) >> 2) * HALF + ((g) & 3) * 16) * DM + col0; \
        _Pragma("unroll") for (int bj_ = 0; bj_ < 2; ++bj_) { if (SRC_F32) { dstv.f[2 * bj_] = *(const f32x4*)((const float*)src + off_ + bj_ * HALF); dstv.f[2 * bj_ + 1] = *(const f32x4*)((const float*)src + off_ + bj_ * HALF + 4); } \
            else dstv.h[bj_] = *(const u32x4*)((const bf16_t*)src + off_ + bj_ * HALF); } } while (0)
        ER_LOAD(cur, 0);
#pragma unroll
        for (int g = 0; g < 8; ++g) {
            if (g < 7) ER_LOAD(nxt, g + 1);
            const size_t off = (size_t)(row0 + (g >> 2) * HALF + (g & 3) * 16) * DM + col0;
#pragma unroll
            for (int bj = 0; bj < 2; ++bj) { f32x4 s0, s1;
                if (SRC_F32) { s0 = cur.f[2 * bj]; s1 = cur.f[2 * bj + 1]; }
                else { const u32x4 hw = cur.h[bj]; s0 = (f32x4){bflo(hw.x), bfhi(hw.x), bflo(hw.y), bfhi(hw.y)}; s1 = (f32x4){bflo(hw.z), bfhi(hw.z), bflo(hw.w), bfhi(hw.w)}; }
                const f32x4 v0 = s0 + acc[g >> 2][bj][g & 3][0] * scale, v1 = s1 + acc[g >> 2][bj][g & 3][1] * scale;
                u32x4 w; w.x = pk2(v0[0], v0[1]); w.y = pk2(v0[2], v0[3]); w.z = pk2(v1[0], v1[1]); w.w = pk2(v1[2], v1[3]);
                *(u32x4*)(dst + off + bj * HALF) = w; }
            cur = nxt;
        }
#undef ER_LOAD
    }
};
struct EpiInGate {
    static constexpr bool PERM = true;
    unsigned char* ws; const float* bgate;
    DI void operator()(const Acc& acc, const Unit& u, int wr, int wc, int fr, int fq) const {
        const int pn = u.pn, row0 = u.pm * BM + wr * 64 + fr, cl0 = wc * 32 + 8 * fq;
        float* U = (float*)(ws + WS_U); bf16_t* GATE = (bf16_t*)(ws + WS_GATE); const float* COS = (const float*)(ws + WS_ROPE); const float* SIN = COS + SEQ * 32;
        if (pn < 2) {
#pragma unroll
            for (int ai = 0; ai < 2; ++ai)
#pragma unroll
                for (int m = 0; m < 4; ++m) { float* rowp = U + (size_t)(row0 + ai * HALF + m * 16) * DSSM + pn * 256 + cl0;
#pragma unroll
                    for (int bj = 0; bj < 2; ++bj)
#pragma unroll
                        for (int n = 0; n < 2; ++n) *(f32x4*)(rowp + bj * HALF + 4 * n) = acc[ai][bj][m][n]; }
        } else if (pn < 10) {
            const bool isq = pn < 6; const int tq = isq ? pn - 2 : pn - 6; bf16_t* dst = (bf16_t*)(ws + (isq ? WS_Q : WS_K)); const float sc = isq ? C2 : 1.0f;
            const int hc = 4 * tq + wc, d0 = 8 * fq;
#pragma unroll
            for (int ai = 0; ai < 2; ++ai)
#pragma unroll
                for (int m = 0; m < 4; ++m) { const int row = row0 + ai * HALF + m * 16, pos = row & (SEQ - 1);
                    const f32x4 c0 = *(const f32x4*)(COS + pos * 32 + d0), c1 = *(const f32x4*)(COS + pos * 32 + d0 + 4);
                    const f32x4 s0 = *(const f32x4*)(SIN + pos * 32 + d0), s1 = *(const f32x4*)(SIN + pos * 32 + d0 + 4);
                    const f32x4 x10 = acc[ai][0][m][0], x11 = acc[ai][0][m][1], x20 = acc[ai][1][m][0], x21 = acc[ai][1][m][1];
                    const f32x4 o10 = (x10 * c0 - x20 * s0) * sc, o11 = (x11 * c1 - x21 * s1) * sc, o20 = (x20 * c0 + x10 * s0) * sc, o21 = (x21 * c1 + x11 * s1) * sc;
                    bf16_t* rp = dst + (size_t)row * DATT + hc * 64 + d0;
                    u32x4 w; w.x = pk2(o10[0], o10[1]); w.y = pk2(o10[2], o10[3]); w.z = pk2(o11[0], o11[1]); w.w = pk2(o11[2], o11[3]); *(u32x4*)rp = w;
                    w.x = pk2(o20[0], o20[1]); w.y = pk2(o20[2], o20[3]); w.z = pk2(o21[0], o21[1]); w.w = pk2(o21[2], o21[3]); *(u32x4*)(rp + 32) = w; }
        } else if (pn < 20) {
            bf16_t* dst; int pitch, colt;
            if (pn < 14) { dst = (bf16_t*)(ws + WS_V); pitch = DATT; colt = (pn - 10) * 256; }
            else { const int which = (pn - 14) >> 1; dst = (bf16_t*)(ws + WS_BG + (size_t)which * (WS_CG - WS_BG)); pitch = DCONV; colt = ((pn - 14) & 1) * 256; }
#pragma unroll
            for (int ai = 0; ai < 2; ++ai)
#pragma unroll
                for (int m = 0; m < 4; ++m) { bf16_t* rp = dst + (size_t)(row0 + ai * HALF + m * 16) * pitch + colt + cl0;
#pragma unroll
                    for (int bj = 0; bj < 2; ++bj) { const f32x4 v0 = acc[ai][bj][m][0], v1 = acc[ai][bj][m][1];
                        u32x4 w; w.x = pk2(v0[0], v0[1]); w.y = pk2(v0[2], v0[3]); w.z = pk2(v1[0], v1[1]); w.w = pk2(v1[2], v1[3]); *(u32x4*)(rp + bj * HALF) = w; } }
        } else {
            const int gc0 = (pn - 20) * 256 + cl0;
            f32x4 bv[2][2];
#pragma unroll
            for (int bj = 0; bj < 2; ++bj)
#pragma unroll
                for (int n = 0; n < 2; ++n) bv[bj][n] = *(const f32x4*)(bgate + gc0 + bj * HALF + 4 * n);
#pragma unroll
            for (int ai = 0; ai < 2; ++ai)
#pragma unroll
                for (int m = 0; m < 4; ++m) { bf16_t* rp = GATE + (size_t)(row0 + ai * HALF + m * 16) * NGATE + gc0;
#pragma unroll
                    for (int bj = 0; bj < 2; ++bj) { const f32x4 v0 = acc[ai][bj][m][0] + bv[bj][0], v1 = acc[ai][bj][m][1] + bv[bj][1];
                        u32x4 w; w.x = pk2(sigmoidf_(v0[0]), sigmoidf_(v0[1])); w.y = pk2(sigmoidf_(v0[2]), sigmoidf_(v0[3]));
                        w.z = pk2(sigmoidf_(v1[0]), sigmoidf_(v1[1])); w.w = pk2(sigmoidf_(v1[2]), sigmoidf_(v1[3])); *(u32x4*)(rp + bj * HALF) = w; } }
        }
    }
};
struct EpiGLU {
    static constexpr bool PERM = true; const bf16_t* YG; bf16_t* YA; const float* bias;
    DI void operator()(const Acc& acc, const Unit& u, int wr, int wc, int fr, int fq) const {
        const int row0 = u.pm * BM + wr * 64 + fr, col0 = u.pn * BM + wc * 32 + 8 * fq;
        f32x4 bv[2][2];
#pragma unroll
        for (int bj = 0; bj < 2; ++bj) { bv[bj][0] = *(const f32x4*)(bias + col0 + bj * HALF); bv[bj][1] = *(const f32x4*)(bias + col0 + bj * HALF + 4); }
        u32x4 cur[2], nxt[2];
#define EG_LOAD(dstv, g) do { const size_t off_ = (size_t)(row0 + ((g) >> 2) * HALF + ((g) & 3) * 16) * DSSM + col0; dstv[0] = *(const u32x4*)(YG + off_); dstv[1] = *(const u32x4*)(YG + off_ + HALF); } while (0)
        EG_LOAD(cur, 0);
#pragma unroll
        for (int g = 0; g < 8; ++g) {
            if (g < 7) EG_LOAD(nxt, g + 1);
            const size_t off = (size_t)(row0 + (g >> 2) * HALF + (g & 3) * 16) * DSSM + col0;
#pragma unroll
            for (int bj = 0; bj < 2; ++bj) { const u32x4 y = cur[bj];
                const f32x4 v0 = acc[g >> 2][bj][g & 3][0] + bv[bj][0], v1 = acc[g >> 2][bj][g & 3][1] + bv[bj][1];
                u32x4 w; w.x = pk2(bflo(y.x) * sigmoidf_(v0[0]), bfhi(y.x) * sigmoidf_(v0[1])); w.y = pk2(bflo(y.y) * sigmoidf_(v0[2]), bfhi(y.y) * sigmoidf_(v0[3]));
                w.z = pk2(bflo(y.z) * sigmoidf_(v1[0]), bfhi(y.z) * sigmoidf_(v1[1])); w.w = pk2(bflo(y.w) * sigmoidf_(v1[2]), bfhi(y.w) * sigmoidf_(v1[3]));
                *(u32x4*)(YA + off + bj * HALF) = w; }
            cur[0] = nxt[0]; cur[1] = nxt[1];
        }
#undef EG_LOAD
    }
};
template <int IDX> struct EpiBranch {
    static constexpr bool PERM = true; const bf16_t* GATE; float* MF; bf16_t* MB;
    DI void operator()(const Acc& acc, const Unit& u, int wr, int wc, int fr, int fq) const {
        const int row0 = u.pm * BM + wr * 64 + fr, col0 = u.pn * BM + wc * 32 + 8 * fq;
        u32x4 gcur[2], gnxt[2], mcur[2], mnxt[2];
#define EB_LOAD(gd, md, g) do { const int row_ = row0 + ((g) >> 2) * HALF + ((g) & 3) * 16; \
        _Pragma("unroll") for (int bj_ = 0; bj_ < 2; ++bj_) { gd[bj_] = *(const u32x4*)(GATE + (size_t)row_ * NGATE + IDX * DM + col0 + bj_ * HALF); \
            if (IDX > 0) md[bj_] = *(const u32x4*)(MB + (size_t)row_ * DM + col0 + bj_ * HALF); } } while (0)
        EB_LOAD(gcur, mcur, 0);
#pragma unroll
        for (int g = 0; g < 8; ++g) {
            if (g < 7) EB_LOAD(gnxt, mnxt, g + 1);
            const int row = row0 + (g >> 2) * HALF + (g & 3) * 16;
#pragma unroll
            for (int bj = 0; bj < 2; ++bj) { const int col = col0 + bj * HALF; const u32x4 gw = gcur[bj];
                f32x4 v0 = acc[g >> 2][bj][g & 3][0], v1 = acc[g >> 2][bj][g & 3][1];
                v0[0] *= bflo(gw.x); v0[1] *= bfhi(gw.x); v0[2] *= bflo(gw.y); v0[3] *= bfhi(gw.y);
                v1[0] *= bflo(gw.z); v1[1] *= bfhi(gw.z); v1[2] *= bflo(gw.w); v1[3] *= bfhi(gw.w);
                if (IDX > 0) { const u32x4 pm_ = mcur[bj];
                    v0[0] += bflo(pm_.x); v0[1] += bfhi(pm_.x); v0[2] += bflo(pm_.y); v0[3] += bfhi(pm_.y);
                    v1[0] += bflo(pm_.z); v1[1] += bfhi(pm_.z); v1[2] += bflo(pm_.w); v1[3] += bfhi(pm_.w); }
                u32x4 w; w.x = pk2(v0[0], v0[1]); w.y = pk2(v0[2], v0[3]); w.z = pk2(v1[0], v1[1]); w.w = pk2(v1[2], v1[3]);
                *(u32x4*)(MB + (size_t)row * DM + col) = w; }
            gcur[0] = gnxt[0]; gcur[1] = gnxt[1];
            if (IDX > 0) { mcur[0] = mnxt[0]; mcur[1] = mnxt[1]; }
        }
#undef EB_LOAD
    }
};
}

DI void transpose_item(const float* W, int ldw, int K, bf16_t* WT, LAS float* scr, int k0, int nsrc0, int ndst0, int lane) {
#pragma unroll 8
    for (int i = 0; i < 32; ++i) { const int kk = 2 * i + (lane >> 5); scr[kk * 33 + (lane & 31)] = W[(size_t)(k0 + kk) * ldw + nsrc0 + (lane & 31)]; }
    LDS_WAIT();
    const int c = lane & 7;
#pragma unroll
    for (int j = 0; j < 4; ++j) { const int n = (lane >> 3) + 8 * j; const LAS float* s = scr + (8 * c) * 33 + n;
        u32x4 o; o.x = pk2(s[0 * 33], s[1 * 33]); o.y = pk2(s[2 * 33], s[3 * 33]); o.z = pk2(s[4 * 33], s[5 * 33]); o.w = pk2(s[6 * 33], s[7 * 33]);
        *(u32x4*)(WT + (size_t)(ndst0 + n) * K + k0 + 8 * c) = o; }
    LDS_WAIT();
}
DI void conv_matrix(const float* W, int ldw, int K, int Ndst, bf16_t* WT, int kind, int gw, int NGW, LAS float* scr, int lane) {
    const int nblk = Ndst / 32, nitems = (K / 64) * nblk;
    for (int it = gw; it < nitems; it += NGW) {
        const int kb = it / nblk, nb = it - kb * nblk, n = 32 * nb; int src = n;
        if (kind == 1) { const int pn = n >> 8, r = n & 255; src = (r < 128) ? 128 * pn + r : DFF + 128 * pn + (r - 128); }
        else if (kind == 2) { if (n >= 512 && n < 2560) { const int n1 = n - 512, t = n1 >> 8, r = n1 & 255, half = r >> 7, i = r & 127, hcl = i >> 5; src = 512 + 256 * t + 64 * hcl + 32 * half; } }
        transpose_item(W, ldw, K, WT, scr, 64 * kb, src, n, lane);
    }
}

template <bool OUT_F32>
DI void norm_rows(const float* X, const float* g, void* out, int gw, int NGW, int lane) {
    for (int m = gw; m < M; m += NGW) {
        const f32x4* xr = (const f32x4*)(X + (size_t)m * DM) + lane;
        f32x4 v[8]; float s = 0.f;
#pragma unroll
        for (int j = 0; j < 8; ++j) { v[j] = xr[64 * j]; s += (v[j][0] * v[j][0] + v[j][1] * v[j][1]) + (v[j][2] * v[j][2] + v[j][3] * v[j][3]); }
        f32x4 gvv[8];
#pragma unroll
        for (int j = 0; j < 8; ++j) gvv[j] = ((const f32x4*)g)[64 * j + lane];
        const float r = 1.0f / sqrtf(wave_sum(s) * (1.0f / DM) + 1e-6f);
#pragma unroll
        for (int j = 0; j < 8; ++j) { const f32x4 o = v[j] * r * gvv[j];
            if (OUT_F32) ((f32x4*)((float*)out + (size_t)m * DM))[64 * j + lane] = o;
            else { u32x2 w; w.x = pk2(o[0], o[1]); w.y = pk2(o[2], o[3]); ((u32x2*)((bf16_t*)out + (size_t)m * DM))[64 * j + lane] = w; } }
    }
}

template <bool OUT_F32>
DI void norm_rows_b(const bf16_t* X, const float* g, void* out, int gw, int NGW, int lane) {
    for (int m = gw; m < M; m += NGW) {
        const u32x4* xr = (const u32x4*)(X + (size_t)m * DM) + lane;
        u32x4 w[4]; float s = 0.f;
#pragma unroll
        for (int j = 0; j < 4; ++j) w[j] = xr[64 * j];
        f32x4 gv[4][2];
#pragma unroll
        for (int j = 0; j < 4; ++j) { gv[j][0] = ((const f32x4*)g)[2 * (64 * j + lane)]; gv[j][1] = ((const f32x4*)g)[2 * (64 * j + lane) + 1]; }
        f32x4 v[4][2];
#pragma unroll
        for (int j = 0; j < 4; ++j) { v[j][0] = (f32x4){bflo(w[j].x), bfhi(w[j].x), bflo(w[j].y), bfhi(w[j].y)}; v[j][1] = (f32x4){bflo(w[j].z), bfhi(w[j].z), bflo(w[j].w), bfhi(w[j].w)};
#pragma unroll
            for (int q = 0; q < 2; ++q) s += (v[j][q][0] * v[j][q][0] + v[j][q][1] * v[j][q][1]) + (v[j][q][2] * v[j][q][2] + v[j][q][3] * v[j][q][3]); }
        const float r = 1.0f / sqrtf(wave_sum(s) * (1.0f / DM) + 1e-6f);
#pragma unroll
        for (int j = 0; j < 4; ++j) { const f32x4 o0 = v[j][0] * r * gv[j][0], o1 = v[j][1] * r * gv[j][1];
            if (OUT_F32) { f32x4* op = (f32x4*)((float*)out + (size_t)m * DM) + 2 * (64 * j + lane); op[0] = o0; op[1] = o1; }
            else { u32x4 ow; ow.x = pk2(o0[0], o0[1]); ow.y = pk2(o0[2], o0[3]); ow.z = pk2(o1[0], o1[1]); ow.w = pk2(o1[2], o1[3]); ((u32x4*)((bf16_t*)out + (size_t)m * DM))[64 * j + lane] = ow; } }
    }
}

constexpr int KP = 272, VP = 288, ATT_STAGE = 64 * KP + 64 * VP, ATT_X = 2 * ATT_STAGE;
static_assert(ATT_X + 65536 <= LDS_BYTES, "attention LDS");
#define MFMA32(a, b, c) __builtin_amdgcn_mfma_f32_32x32x16_bf16((a), (b), (c), 0, 0, 0)
typedef short v4i16_t __attribute__((ext_vector_type(4)));
DI s16x4 vtr(const LAS unsigned char* p) { return __builtin_bit_cast(s16x4, __builtin_amdgcn_ds_read_tr16_b64_v4i16((LAS v4i16_t*)p)); }

template <bool QK, bool PV>
DI void att_step(int t, LAS unsigned char* lds, const bf16_t* kg, const bf16_t* vg, int srow, int sch, int r, int h, int c, int voff0,
                 const bf16x8 (&qf)[4], f32x16 (&O)[4], bf16x8 (&pf)[4], float& mrun, float& lrun) {
    const LAS unsigned char* kbase = lds + (t & 1) * (64 * KP);
    const LAS unsigned char* vbase = lds + 2 * 64 * KP + ((t - 1) & 1) * (64 * VP);
    u32x4 kr[2], vr[2];
    const bool ldk = QK && (t + 1 < 64);
    if (ldk) {
#pragma unroll
        for (int i = 0; i < 2; ++i) kr[i] = *(const u32x4*)(kg + (size_t)((t + 1) * 64 + i * 32) * DATT);
    }
    if (QK) {
#pragma unroll
        for (int i = 0; i < 2; ++i) vr[i] = *(const u32x4*)(vg + (size_t)(t * 64 + i * 32) * DATT);
    }
    f32x16 S[2]; bf16x8 pfn[4]; s16x4 vA[4][2], vB[4][2];
#define VFRAG_LOAD(dstv, dt_) do { _Pragma("unroll") for (int kk_ = 0; kk_ < 4; ++kk_) { \
        const LAS unsigned char* vp_ = vbase + voff0 + (16 * kk_) * VP + 64 * (dt_); dstv[kk_][0] = vtr(vp_); dstv[kk_][1] = vtr(vp_ + 8 * VP); } } while (0)
#define PV_MMA(srcv, dt_) do { _Pragma("unroll") for (int kk_ = 0; kk_ < 4; ++kk_) { \
        const bf16x8 vf_ = __builtin_shufflevector(srcv[kk_][0], srcv[kk_][1], 0, 1, 2, 3, 4, 5, 6, 7); O[dt_] = MFMA32(vf_, pf[kk_], O[dt_]); } } while (0)
    if (QK) {
        bf16x8 kf[2][4];
#pragma unroll
        for (int kti = 0; kti < 2; ++kti)
#pragma unroll
            for (int ks = 0; ks < 4; ++ks) kf[kti][ks] = *(const LAS bf16x8*)(kbase + (32 * kti + r) * KP + c * 128 + (16 * ks + 8 * h) * 2);
        if (PV) VFRAG_LOAD(vA, 0);
        __builtin_amdgcn_sched_barrier(0);
#pragma unroll
        for (int kti = 0; kti < 2; ++kti)
#pragma unroll
            for (int ks = 0; ks < 4; ++ks) { if (ks == 0) { f32x16 z; _Pragma("unroll") for (int i = 0; i < 16; ++i) z[i] = 0.f; S[kti] = MFMA32(kf[kti][ks], qf[ks], z); } else S[kti] = MFMA32(kf[kti][ks], qf[ks], S[kti]); }
        float tm0 = fmaxf(fmaxf(S[0][0], S[0][1]), S[0][2]), tm1 = fmaxf(fmaxf(S[1][0], S[1][1]), S[1][2]);
#pragma unroll
        for (int i = 3; i < 15; i += 2) { tm0 = fmaxf(fmaxf(tm0, S[0][i]), S[0][i + 1]); tm1 = fmaxf(fmaxf(tm1, S[1][i]), S[1][i + 1]); }
        float tmax = fmaxf(fmaxf(tm0, tm1), fmaxf(S[0][15], S[1][15]));
        if (!PV || __builtin_amdgcn_ballot_w64(tmax > mrun + 8.0f) != 0ull) {
            tmax = fmaxf(tmax, __shfl_xor(tmax, 32));
            const float mnew = !PV ? tmax : fmaxf(tmax, mrun);
            const float alpha = !PV ? 1.0f : __builtin_amdgcn_exp2f(mrun - mnew);
            mrun = mnew; lrun *= alpha;
            if (PV) {
#pragma unroll
                for (int dt = 0; dt < 4; ++dt)
#pragma unroll
                    for (int i = 0; i < 16; ++i) O[dt][i] *= alpha;
#pragma unroll
                for (int kk = 0; kk < 4; ++kk) { u32x4 w = __builtin_bit_cast(u32x4, pf[kk]);
                    w.x = pk2(bflo(w.x) * alpha, bfhi(w.x) * alpha); w.y = pk2(bflo(w.y) * alpha, bfhi(w.y) * alpha); w.z = pk2(bflo(w.z) * alpha, bfhi(w.z) * alpha); w.w = pk2(bflo(w.w) * alpha, bfhi(w.w) * alpha);
                    pf[kk] = __builtin_bit_cast(bf16x8, w); }
            }
        }
        __builtin_amdgcn_sched_barrier(0);
    } else {
        VFRAG_LOAD(vA, 0);
    }
    if (PV) VFRAG_LOAD(vB, 1);
    if (QK) {
        f32x2_t ls2 = {0.f, 0.f};
#pragma unroll
        for (int kti = 0; kti < 2; ++kti)
#pragma unroll
            for (int i = 0; i < 16; i += 2) { f32x2_t p2; p2.x = __builtin_amdgcn_exp2f(S[kti][i] - mrun); p2.y = __builtin_amdgcn_exp2f(S[kti][i + 1] - mrun); S[kti][i] = p2.x; S[kti][i + 1] = p2.y; ls2 += p2; }
        lrun += ls2.x + ls2.y;
#pragma unroll
        for (int kk = 0; kk < 4; ++kk) { const int kti = kk >> 1, s = kk & 1; u32x4 w; w.x = pk2(S[kti][8 * s + 0], S[kti][8 * s + 1]); w.y = pk2(S[kti][8 * s + 2], S[kti][8 * s + 3]);
            w.z = pk2(S[kti][8 * s + 4], S[kti][8 * s + 5]); w.w = pk2(S[kti][8 * s + 6], S[kti][8 * s + 7]); pfn[kk] = __builtin_bit_cast(bf16x8, w); }
    }
    if (PV) {
        PV_MMA(vA, 0); VFRAG_LOAD(vA, 2); PV_MMA(vB, 1); VFRAG_LOAD(vB, 3); PV_MMA(vA, 2); PV_MMA(vB, 3);
    }
#ifdef ATT_INTERLEAVE
    if (QK && PV) {
        __builtin_amdgcn_sched_group_barrier(0x100, 8, 0);
#pragma unroll
        for (int gi = 0; gi < 16; ++gi) { __builtin_amdgcn_sched_group_barrier(0x008, 1, 0); __builtin_amdgcn_sched_group_barrier(0x402, 6, 0); if (gi == 1 || gi == 5) __builtin_amdgcn_sched_group_barrier(0x100, 8, 0); }
    }
#endif
    __builtin_amdgcn_sched_barrier(0);
    if (QK) {
#pragma unroll
        for (int kk = 0; kk < 4; ++kk) pf[kk] = pfn[kk];
        LAS unsigned char* nk = lds + ((t + 1) & 1) * (64 * KP); LAS unsigned char* nv = lds + 2 * 64 * KP + (t & 1) * (64 * VP);
        if (ldk) {
#pragma unroll
            for (int i = 0; i < 2; ++i) *(LAS u32x4*)(nk + (srow + 32 * i) * KP + sch * 16) = kr[i];
        }
#pragma unroll
        for (int i = 0; i < 2; ++i) *(LAS u32x4*)(nv + (srow + 32 * i) * VP + sch * 16) = vr[i];
    }
    __syncthreads();
#undef VFRAG_LOAD
#undef PV_MMA
}

DI void attn_phase(LAS unsigned char* lds, const bf16_t* Q, const bf16_t* K, const bf16_t* V, bf16_t* YB, const float* lamvec, const float* subln, float lambda_init, int vcu, int G) {
    int tid_ = threadIdx.x; asm volatile("" : "+v"(tid_));
    const int tid = tid_, lane = tid & 63, wave = __builtin_amdgcn_readfirstlane(tid >> 6), r = lane & 31, h = lane >> 5, qs = wave & 3, c = wave >> 2;
    const float lam = __expf(wave_sum(lamvec[lane] * lamvec[64 + lane])) - __expf(wave_sum(lamvec[128 + lane] * lamvec[192 + lane])) + lambda_init;
    const int srow = tid >> 4, sch = tid & 15;
    const int tq = (lane & 15) >> 2, tp = lane & 3, blk = (lane >> 4) & 1;
    for (int item = vcu; item < 512; item += G) {
        const int pair = item >> 5, qb = item & 31, b = pair >> 3, hd = pair & 7;
        const int rowq = b * SEQ + qb * 128 + qs * 32 + r;
        bf16x8 qf[4];
#pragma unroll
        for (int ks = 0; ks < 4; ++ks) qf[ks] = *(const bf16x8*)(Q + (size_t)rowq * DATT + hd * 128 + c * 64 + 16 * ks + 8 * h);
        f32x16 O[4];
#pragma unroll
        for (int dt = 0; dt < 4; ++dt)
#pragma unroll
            for (int i = 0; i < 16; ++i) O[dt][i] = 0.f;
        float mrun = 0.f, lrun = 0.f;
        const bf16_t* kg = K + (size_t)(b * SEQ + srow) * DATT + hd * 128 + sch * 8;
        const bf16_t* vg = V + (size_t)(b * SEQ + srow) * DATT + hd * 128 + sch * 8;
        u32x4 kr[2], vr[2];
#pragma unroll
        for (int i = 0; i < 2; ++i) kr[i] = *(const u32x4*)(kg + (size_t)(i * 32) * DATT);
#pragma unroll
        for (int i = 0; i < 2; ++i) *(LAS u32x4*)(lds + (srow + 32 * i) * KP + sch * 16) = kr[i];
        __syncthreads();
        bf16x8 pf[4];
#pragma unroll
        for (int i = 0; i < 4; ++i) pf[i] = (bf16x8){0, 0, 0, 0, 0, 0, 0, 0};
        const int voff0 = (4 * h + tq) * VP + (16 * blk) * 2 + 8 * tp;
        att_step<true, false>(0, lds, kg, vg, srow, sch, r, h, c, voff0, qf, O, pf, mrun, lrun);
        for (int t = 1; t < 64; ++t) att_step<true, true>(t, lds, kg, vg, srow, sch, r, h, c, voff0, qf, O, pf, mrun, lrun);
        att_step<false, true>(64, lds, kg, vg, srow, sch, r, h, c, voff0, qf, O, pf, mrun, lrun);
        const float ltot = lrun + __shfl_xor(lrun, 32), inv = 1.0f / ltot;
        LAS float* X = (LAS float*)(lds + ATT_X + qs * 16384);
        if (c == 1) { const float sc = lam * inv;
#pragma unroll
            for (int dt = 0; dt < 4; ++dt)
#pragma unroll
                for (int i = 0; i < 16; ++i) X[(dt * 16 + i) * 64 + lane] = O[dt][i] * sc; }
        __syncthreads();
        if (c == 0) {
            float ss = 0.f;
#pragma unroll
            for (int dt = 0; dt < 4; ++dt)
#pragma unroll
                for (int i = 0; i < 16; ++i) { const float o = O[dt][i] * inv - X[(dt * 16 + i) * 64 + lane]; O[dt][i] = o; ss += o * o; }
            ss += __shfl_xor(ss, 32);
            const float rn = (1.0f / sqrtf(ss * (1.0f / 128.0f) + 1e-6f)) * (1.0f - lambda_init);
            bf16_t* op = YB + (size_t)rowq * DATT + hd * 128;
#pragma unroll
            for (int dt = 0; dt < 4; ++dt)
#pragma unroll
                for (int g4 = 0; g4 < 4; ++g4) { const int d = 32 * dt + 8 * g4 + 4 * h; const f32x4 gv = *(const f32x4*)(subln + d);
                    u32x2 w; w.x = pk2(O[dt][4 * g4 + 0] * rn * gv[0], O[dt][4 * g4 + 1] * rn * gv[1]); w.y = pk2(O[dt][4 * g4 + 2] * rn * gv[2], O[dt][4 * g4 + 3] * rn * gv[3]);
                    *(u32x2*)(op + d) = w; }
        }
        __syncthreads();
    }
}

constexpr int S5_WAVE_LDS = 12800, S5_SP = 132;
struct S5Par { float ar, ai, cr, ci; };
DI S5Par s5_par(const float* lre, const float* lim, const float* ldt, int dir, int g, int n) {
    const float dt = expf(ldt[dir * 32 + g]), lr = lre[(dir * 32 + g) * 64 + n], li = lim[(dir * 32 + g) * 64 + n];
    const float mag = expf(dt * lr); S5Par p; p.ar = mag * cosf(dt * li); p.ai = mag * sinf(dt * li);
    const float den = lr * lr + li * li, nr = p.ar - 1.0f; p.cr = (nr * lr + p.ai * li) / den; p.ci = (p.ai * lr - nr * li) / den; return p;
}
DI void s5_load_u(LAS float* us, const float* U, int b, int g, int c, int lane) {
    const f32x4* up = (const f32x4*)(U + (size_t)(b * SEQ + c * 64 + lane) * DSSM + g * 16);
#pragma unroll
    for (int j = 0; j < 4; ++j) *(LAS f32x4*)(us + lane * 16 + 4 * j) = up[j];
    LDS_WAIT(); __builtin_amdgcn_wave_barrier();
}
DI void s5_bu(const LAS float* us, int t, const float (&Bre)[16], const float (&Bim)[16], float& bur, float& bui) {
    float r0 = 0.f, r1 = 0.f, i0 = 0.f, i1 = 0.f;
#pragma unroll
    for (int j = 0; j < 4; ++j) { const f32x4 u = *(const LAS f32x4*)(us + t * 16 + 4 * j);
        r0 += u[0] * Bre[4 * j + 0]; r1 += u[1] * Bre[4 * j + 1]; r0 += u[2] * Bre[4 * j + 2]; r1 += u[3] * Bre[4 * j + 3];
        i0 += u[0] * Bim[4 * j + 0]; i1 += u[1] * Bim[4 * j + 1]; i0 += u[2] * Bim[4 * j + 2]; i1 += u[3] * Bim[4 * j + 3]; }
    bur = r0 + r1; bui = i0 + i1;
}
struct URow { f32x4 v[4]; };
DI URow s5_ldu(const LAS float* us, int t) { URow u;
#pragma unroll
    for (int j = 0; j < 4; ++j) u.v[j] = *(const LAS f32x4*)(us + t * 16 + 4 * j);
    return u; }
DI void s5_bu_r(const URow& u, const float (&Bre)[16], const float (&Bim)[16], float& bur, float& bui) {
    float r0 = 0.f, r1 = 0.f, i0 = 0.f, i1 = 0.f;
#pragma unroll
    for (int j = 0; j < 4; ++j) {
        r0 += u.v[j][0] * Bre[4 * j + 0]; r1 += u.v[j][1] * Bre[4 * j + 1]; r0 += u.v[j][2] * Bre[4 * j + 2]; r1 += u.v[j][3] * Bre[4 * j + 3];
        i0 += u.v[j][0] * Bim[4 * j + 0]; i1 += u.v[j][1] * Bim[4 * j + 1]; i0 += u.v[j][2] * Bim[4 * j + 2]; i1 += u.v[j][3] * Bim[4 * j + 3]; }
    bur = r0 + r1; bui = i0 + i1;
}
DI void s5_pass1(LAS unsigned char* lds, const float* U, float* SE, const float* lre, const float* lim, const float* ldt, const float* bre, const float* bim, int gw, int NGW) {
    int tid_ = threadIdx.x; asm volatile("" : "+v"(tid_));
    const int lane = tid_ & 63, wave = __builtin_amdgcn_readfirstlane(tid_ >> 6);
    LAS float* us = (LAS float*)(lds + wave * S5_WAVE_LDS);
    for (int item = gw; item < 4096; item += NGW) {
        const int c = item & 63, bg = item >> 6, g = bg & 31, b = bg >> 5;
        const S5Par pf = s5_par(lre, lim, ldt, 0, g, lane), pb = s5_par(lre, lim, ldt, 1, g, lane);
        float Bre[16], Bim[16];
#pragma unroll
        for (int j = 0; j < 4; ++j) { const f32x4 a = *(const f32x4*)(bre + (size_t)(g * 64 + lane) * 16 + 4 * j), bb = *(const f32x4*)(bim + (size_t)(g * 64 + lane) * 16 + 4 * j);
#pragma unroll
            for (int e = 0; e < 4; ++e) { Bre[4 * j + e] = a[e]; Bim[4 * j + e] = bb[e]; } }
        s5_load_u(us, U, b, g, c, lane);
        float efr = 0.f, efi = 0.f, ebr = 0.f, ebi = 0.f, pwr = 1.f, pwi = 0.f;
#pragma unroll 4
        for (int t = 0; t < 64; ++t) {
            float bur, bui; s5_bu(us, t, Bre, Bim, bur, bui);
            const float fr_ = pf.cr * bur - pf.ci * bui, fi_ = pf.cr * bui + pf.ci * bur;
            const float nfr = pf.ar * efr - pf.ai * efi + fr_, nfi = pf.ar * efi + pf.ai * efr + fi_; efr = nfr; efi = nfi;
            const float br_ = pb.cr * bur - pb.ci * bui, bi_ = pb.cr * bui + pb.ci * bur;
            ebr += pwr * br_ - pwi * bi_; ebi += pwr * bi_ + pwi * br_;
            const float npr = pwr * pb.ar - pwi * pb.ai, npi = pwr * pb.ai + pwi * pb.ar; pwr = npr; pwi = npi;
        }
        float* se = SE + (size_t)item * 256 + lane; se[0] = efr; se[64] = efi; se[128] = ebr; se[192] = ebi;
        __builtin_amdgcn_wave_barrier();
    }
}
DI void s5_pass2(LAS unsigned char* lds, const float* U, const float* SE, bf16_t* YG, const float* lre, const float* lim, const float* ldt, const float* bre, const float* bim,
                 const float* cre, const float* cim, const float* dsk, int gw, int NGW) {
    int tid_ = threadIdx.x; asm volatile("" : "+v"(tid_));
    const int lane = tid_ & 63, wave = __builtin_amdgcn_readfirstlane(tid_ >> 6), l15 = lane & 15, l4 = lane >> 4;
    LAS float* us = (LAS float*)(lds + wave * S5_WAVE_LDS); LAS float* Ss = us + 1024;
    for (int item = gw; item < 4096; item += NGW) {
        const int c = item & 63, bg = item >> 6, g = bg & 31, b = bg >> 5;
        const S5Par pf = s5_par(lre, lim, ldt, 0, g, lane), pb = s5_par(lre, lim, ldt, 1, g, lane);
        float Bre[16], Bim[16], Cm[32];
#pragma unroll
        for (int j = 0; j < 4; ++j) { const f32x4 a = *(const f32x4*)(bre + (size_t)(g * 64 + lane) * 16 + 4 * j), bb = *(const f32x4*)(bim + (size_t)(g * 64 + lane) * 16 + 4 * j);
#pragma unroll
            for (int e = 0; e < 4; ++e) { Bre[4 * j + e] = a[e]; Bim[4 * j + e] = bb[e]; } }
#pragma unroll
        for (int m = 0; m < 16; ++m) { Cm[m] = cre[(size_t)(g * 16 + l15) * 64 + 4 * m + l4]; Cm[16 + m] = -cim[(size_t)(g * 16 + l15) * 64 + 4 * m + l4]; }
        s5_load_u(us, U, b, g, c, lane);
        float afr = pf.ar, afi = pf.ai, abr = pb.ar, abi = pb.ai;
#pragma unroll
        for (int i = 0; i < 6; ++i) { const float x = afr * afr - afi * afi, y = 2.f * afr * afi; afr = x; afi = y; const float z = abr * abr - abi * abi, w = 2.f * abr * abi; abr = z; abi = w; }
        float sfr = 0.f, sfi = 0.f, sbr = 0.f, sbi = 0.f;
        const float* seb = SE + (size_t)(bg * 64) * 256 + lane;
#pragma unroll 1
        for (int c8 = 0; c8 < 64; c8 += 8) {
            float er[8], ei[8], br[8], bi[8];
#pragma unroll
            for (int j = 0; j < 8; ++j) { er[j] = seb[(size_t)(c8 + j) * 256]; ei[j] = seb[(size_t)(c8 + j) * 256 + 64]; br[j] = seb[(size_t)(63 - c8 - j) * 256 + 128]; bi[j] = seb[(size_t)(63 - c8 - j) * 256 + 192]; }
#pragma unroll
            for (int j = 0; j < 8; ++j) {
                if (c8 + j < c) { const float x = afr * sfr - afi * sfi + er[j], y = afr * sfi + afi * sfr + ei[j]; sfr = x; sfi = y; }
                if (63 - c8 - j > c) { const float x = abr * sbr - abi * sbi + br[j], y = abr * sbi + abi * sbr + bi[j]; sbr = x; sbi = y; }
            }
        }
        f32x4 Y[4];
#pragma unroll
        for (int s = 0; s < 4; ++s) Y[s] = (f32x4){0.f, 0.f, 0.f, 0.f};
#pragma unroll
        for (int sub = 0; sub < 4; ++sub) {
            URow ucur = s5_ldu(us, 16 * sub);
#pragma unroll 4
            for (int tt = 0; tt < 16; ++tt) {
                const URow unxt = s5_ldu(us, (16 * sub + tt + 1) & 63);
                float bur, bui; s5_bu_r(ucur, Bre, Bim, bur, bui); ucur = unxt;
                const float fr_ = pf.cr * bur - pf.ci * bui, fi_ = pf.cr * bui + pf.ci * bur;
                const float x = pf.ar * sfr - pf.ai * sfi + fr_, y = pf.ar * sfi + pf.ai * sfr + fi_; sfr = x; sfi = y;
                Ss[tt * S5_SP + lane] = sfr; Ss[tt * S5_SP + 64 + lane] = sfi;
            }
            LDS_WAIT(); __builtin_amdgcn_wave_barrier();
#pragma unroll
            for (int m = 0; m < 32; ++m) { const float bv = Ss[l15 * S5_SP + 4 * m + l4]; Y[sub] = __builtin_amdgcn_mfma_f32_16x16x4f32(Cm[m], bv, Y[sub], 0, 0, 0); }
            LDS_WAIT(); __builtin_amdgcn_wave_barrier();
        }
#pragma unroll
        for (int sub = 3; sub >= 0; --sub) {
            URow ucur = s5_ldu(us, 16 * sub + 15);
#pragma unroll 4
            for (int tt = 15; tt >= 0; --tt) {
                const URow unxt = s5_ldu(us, (16 * sub + tt - 1) & 63);
                float bur, bui; s5_bu_r(ucur, Bre, Bim, bur, bui); ucur = unxt;
                const float br_ = pb.cr * bur - pb.ci * bui, bi_ = pb.cr * bui + pb.ci * bur;
                const float x = pb.ar * sbr - pb.ai * sbi + br_, y = pb.ar * sbi + pb.ai * sbr + bi_; sbr = x; sbi = y;
                Ss[tt * S5_SP + lane] = sbr; Ss[tt * S5_SP + 64 + lane] = sbi;
            }
            LDS_WAIT(); __builtin_amdgcn_wave_barrier();
#pragma unroll
            for (int m = 0; m < 32; ++m) { const float bv = Ss[l15 * S5_SP + 4 * m + l4]; Y[sub] = __builtin_amdgcn_mfma_f32_16x16x4f32(Cm[m], bv, Y[sub], 0, 0, 0); }
            LDS_WAIT(); __builtin_amdgcn_wave_barrier();
        }
        const f32x4 dv = *(const f32x4*)(dsk + g * 16 + 4 * l4);
#pragma unroll
        for (int sub = 0; sub < 4; ++sub) { const int t = 16 * sub + l15; const f32x4 uv = *(const LAS f32x4*)(us + t * 16 + 4 * l4);
            float y[4];
#pragma unroll
            for (int v = 0; v < 4; ++v) y[v] = gelu_tanh(Y[sub][v] + dv[v] * uv[v]);
            u32x2 w; w.x = pk2(y[0], y[1]); w.y = pk2(y[2], y[3]);
            *(u32x2*)(YG + (size_t)(b * SEQ + c * 64 + t) * DSSM + g * 16 + 4 * l4) = w; }
        LDS_WAIT(); __builtin_amdgcn_wave_barrier();
    }
}

DI void conv_phase(const bf16_t* BG, const bf16_t* CG, const bf16_t* XV, const float* cw, bf16_t* YC, int gt, int NT) {
    for (int idx = gt; idx < M * 64; idx += NT) {
        const int row = idx >> 6, ch = (idx & 63) * 8, t = row & (SEQ - 1);
        const size_t o = (size_t)row * DCONV + ch;
        const u32x4 zero = {0u, 0u, 0u, 0u};
        const u32x4 c1 = *(const u32x4*)(CG + o), x1 = *(const u32x4*)(XV + o), bgv = *(const u32x4*)(BG + o);
        const u32x4 c0 = t > 0 ? *(const u32x4*)(CG + o - DCONV) : zero, x0 = t > 0 ? *(const u32x4*)(XV + o - DCONV) : zero;
        const u32x4 c2 = t < SEQ - 1 ? *(const u32x4*)(CG + o + DCONV) : zero, x2 = t < SEQ - 1 ? *(const u32x4*)(XV + o + DCONV) : zero;
        float y[8];
#pragma unroll
        for (int j = 0; j < 4; ++j) {
            const float w0a = cw[ch + 2 * j], w0b = cw[ch + 2 * j + 1], w1a = cw[DCONV + ch + 2 * j], w1b = cw[DCONV + ch + 2 * j + 1], w2a = cw[2 * DCONV + ch + 2 * j], w2b = cw[2 * DCONV + ch + 2 * j + 1];
            y[2 * j] = bflo(bgv[j]) * (w0a * bflo(c0[j]) * bflo(x0[j]) + w1a * bflo(c1[j]) * bflo(x1[j]) + w2a * bflo(c2[j]) * bflo(x2[j]));
            y[2 * j + 1] = bfhi(bgv[j]) * (w0b * bfhi(c0[j]) * bfhi(x0[j]) + w1b * bfhi(c1[j]) * bfhi(x1[j]) + w2b * bfhi(c2[j]) * bfhi(x2[j]));
        }
        u32x4 w; w.x = pk2(y[0], y[1]); w.y = pk2(y[2], y[3]); w.z = pk2(y[4], y[5]); w.w = pk2(y[6], y[7]);
        *(u32x4*)(YC + o) = w;
    }
}

#define XB_TMO      128
#define XB_XCNT(j)  (256  + 64 * (j))
#define XB_XSUB(j)  (1280 + 64 * (j))
#define XB_XGEN(j)  (2304 + 64 * (j))
#define XB_TOP      3328
#define XB_TOPGEN   3392
#define XCD_BAR_WORDS 3456
#define XB_SPIN_CAP (1u << 18)
DI unsigned xb_ld(unsigned* p)              { return __hip_atomic_load(p, __ATOMIC_RELAXED, __HIP_MEMORY_SCOPE_AGENT); }
DI unsigned xb_add(unsigned* p, unsigned v) { return __hip_atomic_fetch_add(p, v, __ATOMIC_RELAXED, __HIP_MEMORY_SCOPE_AGENT); }
DI unsigned xb_xcc_id() { return (unsigned)__builtin_amdgcn_s_getreg((3 << 11) | 20) & 0xFu; }
#define XB_SPIN(cond, bar) do { unsigned _sp = 0; while (cond) { __builtin_amdgcn_s_sleep(1); \
    if ((++_sp & 255u) == 0u) { if (xb_ld(&(bar)[XB_TMO])) break; if (_sp > XB_SPIN_CAP) { atomicAdd(&(bar)[XB_TMO], 1u); break; } } } } while (0)
struct XcdBarrier { unsigned* bar; unsigned x; volatile LAS unsigned* st; };
DI XcdBarrier xcd_barrier_post(unsigned* bar, volatile LAS unsigned* st) {
    XcdBarrier b; b.bar = bar; b.x = xb_xcc_id(); b.st = st;
    if (threadIdx.x == 0) (void)xb_add(&bar[XB_XCNT(b.x)], 1u);
    return b;
}
DI void xcd_barrier_complete(unsigned* bar, unsigned x, unsigned& nloc, unsigned& nx) {
    const unsigned G = gridDim.x * gridDim.y * gridDim.z;
    unsigned sum, cnt, mine, sp = 0u;
    for (;;) {
        sum = 0u; cnt = 0u; mine = 0u;
#pragma unroll
        for (unsigned j = 0; j < 16; ++j) { const unsigned c = xb_ld(&bar[XB_XCNT(j)]); sum += c; cnt += (c > 0u) ? 1u : 0u; mine = (j == x) ? c : mine; }
        if (sum == G) break;
        __builtin_amdgcn_s_sleep(1);
        if ((++sp & 255u) == 0u) { if (xb_ld(&bar[XB_TMO])) break; if (sp > XB_SPIN_CAP) { atomicAdd(&bar[XB_TMO], 1u); break; } }
    }
    nloc = mine > 0u ? mine : 1u; nx = cnt > 0u ? cnt : 1u;
}
DI void xcd_barrier(const XcdBarrier& b) {
    asm volatile("s_waitcnt vmcnt(0)" ::: "memory");
    __syncthreads();
    if (threadIdx.x == 0) {
        unsigned* bar = b.bar;
        __builtin_amdgcn_s_waitcnt(0);
        unsigned nloc = b.st[0], nx = b.st[1];
        if (nloc == 0u) { xcd_barrier_complete(bar, b.x, nloc, nx); b.st[0] = nloc; b.st[1] = nx; }
        const unsigned old = xb_add(&bar[XB_XSUB(b.x)], 1u);
        const unsigned gen = old / nloc;
        if (old + 1u == (gen + 1u) * nloc) {
            __builtin_amdgcn_fence(__ATOMIC_RELEASE, "agent");
            asm volatile("s_waitcnt vmcnt(0)" ::: "memory");
            const unsigned og = xb_add(&bar[XB_TOP], 1u);
            const unsigned tg = og / nx;
            if (og + 1u == (tg + 1u) * nx) xb_add(&bar[XB_TOPGEN], 1u);
            else XB_SPIN(xb_ld(&bar[XB_TOPGEN]) == tg, bar);
            __builtin_amdgcn_fence(__ATOMIC_ACQUIRE, "agent");
            xb_add(&bar[XB_XGEN(b.x)], 1u);
            asm volatile("s_waitcnt vmcnt(0)" ::: "memory");
        } else {
            XB_SPIN(xb_ld(&bar[XB_XGEN(b.x)]) == gen, bar);
            __builtin_amdgcn_fence(__ATOMIC_ACQUIRE, "agent");
            asm volatile("s_waitcnt vmcnt(0)" ::: "memory");
        }
    }
    __syncthreads();
}

#ifndef REP_PREP
#define REP_PREP 1
#endif
#ifndef REP_NORM
#define REP_NORM 1
#endif
#ifndef REP_ATT
#define REP_ATT 1
#endif
#ifndef REP_S5
#define REP_S5 1
#endif
#ifndef REP_SYNC
#define REP_SYNC 1
#endif
#define GSYNC() do { for (int rs_ = 0; rs_ < REP_SYNC; ++rs_) xcd_barrier(xbar); } while (0)
struct Params { const float* in[23]; float* out; unsigned char* ws; };
template <int OFF> DI unsigned long long karg_u64() { unsigned long long v; auto ka = __builtin_amdgcn_kernarg_segment_ptr();
    asm volatile("s_load_dwordx2 %0, %1, %2\n\ts_waitcnt lgkmcnt(0)" : "=s"(v) : "s"(ka), "n"(OFF) : "memory"); return v; }
#define ARG_IN(i) ((const float*)(const __attribute__((address_space(1))) float*)karg_u64<8 * (i)>())
#define ARG_OUT() ((float*)(__attribute__((address_space(1))) float*)karg_u64<8 * 23>())
#define ARG_WS() ((unsigned char*)(__attribute__((address_space(1))) unsigned char*)karg_u64<8 * 24>())

__global__ void __launch_bounds__(512, 2) fwd_megakernel(Params p) {
    extern __shared__ __attribute__((aligned(16))) unsigned char lds_raw[];
    LAS unsigned char* lds = (LAS unsigned char*)lds_raw;
    cg::grid_group grid = cg::this_grid();
    const int G = gridDim.x, bid = blockIdx.x;
    if (threadIdx.x < 16) ((LAS unsigned*)(lds + LDS_MISC))[threadIdx.x] = 0u;
    if (bid == 0) { unsigned* bw = (unsigned*)(ARG_WS() + WS_BAR); for (int i = threadIdx.x; i < XCD_BAR_WORDS; i += 512) bw[i] = 0u; }
    __syncthreads();
#define IDS() int tidk = threadIdx.x; asm volatile("" : "+v"(tidk)); const int lane = tidk & 63, wave = __builtin_amdgcn_readfirstlane(tidk >> 6); \
    const int gw = bid * 8 + wave, NGW = G * 8, gt = bid * 512 + tidk, NT = G * 512; (void)lane; (void)gw; (void)NGW; (void)gt; (void)NT

    for (int rep_ = 0; rep_ < REP_PREP; ++rep_) {
        IDS(); unsigned char* ws = ARG_WS();
        LAS float* scr = (LAS float*)(lds + wave * 16384);
        { const float* w13 = ARG_IN(2); for (int i = 0; i < 4; ++i) conv_matrix(w13 + (size_t)i * DM * 2 * DFF, 2 * DFF, DM, 2 * DFF, (bf16_t*)(ws + WS_W13T + i * SZ_W13T), 1, gw, NGW, scr, lane); }
        { const float* w2 = ARG_IN(3); for (int i = 0; i < 4; ++i) conv_matrix(w2 + (size_t)i * DFF * DM, DM, DFF, DM, (bf16_t*)(ws + WS_W2T + i * SZ_W2T), 0, gw, NGW, scr, lane); }
        for (int l = 0; l < 2; ++l) {
            bf16_t* wc = (bf16_t*)(ws + WS_WCOMB + l * SZ_WCOMB);
            conv_matrix(ARG_IN(4) + (size_t)l * DM * DIN, DIN, DM, DIN, wc, 2, gw, NGW, scr, lane);
            conv_matrix(ARG_IN(19) + (size_t)l * DM * NGATE, NGATE, DM, NGATE, wc + (size_t)DIN * DM, 0, gw, NGW, scr, lane);
            conv_matrix(ARG_IN(13) + (size_t)l * DSSM * DSSM, DSSM, DSSM, DSSM, (bf16_t*)(ws + WS_WGLU + l * SZ_WGLU), 0, gw, NGW, scr, lane);
            bf16_t* wb = (bf16_t*)(ws + WS_WBR + l * SZ_WBR); const float* wbs = ARG_IN(18) + (size_t)l * DM * DM;
            conv_matrix(wbs, DM, DSSM, DM, wb, 0, gw, NGW, scr, lane);
            conv_matrix(wbs + (size_t)DSSM * DM, DM, DATT, DM, wb + (size_t)DM * DSSM, 0, gw, NGW, scr, lane);
            conv_matrix(wbs + (size_t)(DSSM + DATT) * DM, DM, DCONV, DM, wb + (size_t)DM * (DSSM + DATT), 0, gw, NGW, scr, lane);
            conv_matrix(ARG_IN(21) + (size_t)l * DM * DM, DM, DM, DM, (bf16_t*)(ws + WS_WOUT + l * SZ_WOUT), 0, gw, NGW, scr, lane);
        }
        float* COS = (float*)(ws + WS_ROPE); float* SIN = COS + SEQ * 32;
        for (int idx = gt; idx < SEQ * 32; idx += NT) { const int pos = idx >> 5, d = idx & 31; const float inv = powf(10000.0f, -(float)(2 * d) / 64.0f); const float ang = (float)pos * inv; COS[idx] = cosf(ang); SIN[idx] = sinf(ang); }
    }
    grid.sync();
    XcdBarrier xbar = xcd_barrier_post((unsigned*)(ARG_WS() + WS_BAR), (volatile LAS unsigned*)(lds + LDS_MISC));

    for (int l = 0; l < DEPTH; ++l) {
        { IDS(); unsigned char* ws = ARG_WS();
          if (l == 0) norm_rows<false>(ARG_IN(0), ARG_IN(1) + (size_t)(l * 3 + 0) * DM, ws + WS_H, gw, NGW, lane);
          else norm_rows_b<false>((const bf16_t*)(ws + WS_X), ARG_IN(1) + (size_t)(l * 3 + 0) * DM, ws + WS_H, gw, NGW, lane); }
        GSYNC();
        { unsigned char* ws = ARG_WS(); pg8::Gemm g{(const bf16_t*)(ws + WS_H), (const bf16_t*)(ws + WS_W13T + (size_t)(l * 2 + 0) * SZ_W13T), M, 2 * DFF, DM}; pg8::StaticOrder S; S.init(M, 2 * DFF, G, bid);
          pg8::EpiSwiglu E{(bf16_t*)(ws + WS_ACT)}; pg8::gemm_phase(lds, g, S, E); }
        GSYNC();
        { unsigned char* ws = ARG_WS();
          pg8::Gemm g{(const bf16_t*)(ws + WS_ACT), (const bf16_t*)(ws + WS_W2T + (size_t)(l * 2 + 0) * SZ_W2T), M, DM, DFF}; pg8::StaticOrder S; S.init(M, DM, G, bid);
          if (l == 0) { pg8::EpiResid<true> E{(const void*)ARG_IN(0), (bf16_t*)(ws + WS_X), 0.5f}; pg8::gemm_phase(lds, g, S, E); }
          else { pg8::EpiResid<false> E{(const void*)(ws + WS_X), (bf16_t*)(ws + WS_X), 0.5f}; pg8::gemm_phase(lds, g, S, E); } }
        GSYNC();
        for (int rep_ = 0; rep_ < REP_NORM; ++rep_) { IDS(); unsigned char* ws = ARG_WS(); norm_rows_b<false>((const bf16_t*)(ws + WS_X), ARG_IN(1) + (size_t)(l * 3 + 1) * DM, ws + WS_H, gw, NGW, lane); }
        GSYNC();
        { unsigned char* ws = ARG_WS(); pg8::Gemm g{(const bf16_t*)(ws + WS_H), (const bf16_t*)(ws + WS_WCOMB + (size_t)l * SZ_WCOMB), M, NCOMB, DM}; pg8::StaticOrder S; S.init(M, NCOMB, G, bid);
          pg8::EpiInGate E{ws, ARG_IN(20) + (size_t)l * NGATE};
          pg8::gemm_phase(lds, g, S, E); }
        GSYNC();
        for (int rep_ = 0; rep_ < REP_S5; ++rep_) { IDS(); unsigned char* ws = ARG_WS();
          s5_pass1(lds, (const float*)(ws + WS_U), (float*)(ws + WS_SE), ARG_IN(5) + (size_t)l * 4096, ARG_IN(6) + (size_t)l * 4096, ARG_IN(7) + (size_t)l * 64,
                   ARG_IN(8) + (size_t)l * 32768, ARG_IN(9) + (size_t)l * 32768, gw, NGW);
          conv_phase((const bf16_t*)(ws + WS_BG), (const bf16_t*)(ws + WS_CG), (const bf16_t*)(ws + WS_XV), ARG_IN(17) + (size_t)l * 3 * DCONV, (bf16_t*)(ws + WS_YC), gt, NT); }
        GSYNC();
        for (int rep_ = 0; rep_ < REP_ATT; ++rep_) { unsigned char* ws = ARG_WS(); const float lambda_init = 0.8f - 0.6f * expf(-0.3f * (float)l);
          const int vcu = (G % 8 == 0) ? (bid % 8) * (G / 8) + bid / 8 : bid;
          attn_phase(lds, (const bf16_t*)(ws + WS_Q), (const bf16_t*)(ws + WS_K), (const bf16_t*)(ws + WS_V), (bf16_t*)(ws + WS_YB), ARG_IN(15) + (size_t)l * 256, ARG_IN(16) + (size_t)l * 128, lambda_init, vcu, G); }
        for (int rep_ = 0; rep_ < REP_S5; ++rep_) { IDS(); unsigned char* ws = ARG_WS();
          s5_pass2(lds, (const float*)(ws + WS_U), (const float*)(ws + WS_SE), (bf16_t*)(ws + WS_YG), ARG_IN(5) + (size_t)l * 4096, ARG_IN(6) + (size_t)l * 4096, ARG_IN(7) + (size_t)l * 64,
                   ARG_IN(8) + (size_t)l * 32768, ARG_IN(9) + (size_t)l * 32768, ARG_IN(10) + (size_t)l * 32768, ARG_IN(11) + (size_t)l * 32768, ARG_IN(12) + (size_t)l * DSSM, gw, NGW); }
        GSYNC();
        { unsigned char* ws = ARG_WS(); pg8::Gemm g{(const bf16_t*)(ws + WS_YG), (const bf16_t*)(ws + WS_WGLU + (size_t)l * SZ_WGLU), M, DSSM, DSSM}; pg8::StaticOrder S; S.init(M, DSSM, G, bid);
          pg8::EpiGLU E{(const bf16_t*)(ws + WS_YG), (bf16_t*)(ws + WS_YA), ARG_IN(14) + (size_t)l * DSSM}; pg8::gemm_phase(lds, g, S, E); }
        GSYNC();
        { unsigned char* ws = ARG_WS(); const bf16_t* wb = (const bf16_t*)(ws + WS_WBR + (size_t)l * SZ_WBR); pg8::StaticOrder S; S.init(M, DM, G, bid);
          pg8::Gemm g{(const bf16_t*)(ws + WS_YA), wb, M, DM, DSSM}; pg8::EpiBranch<0> E{(const bf16_t*)(ws + WS_GATE), (float*)(ws + WS_MF), (bf16_t*)(ws + WS_MB)}; pg8::gemm_phase(lds, g, S, E); }
        { unsigned char* ws = ARG_WS(); const bf16_t* wb = (const bf16_t*)(ws + WS_WBR + (size_t)l * SZ_WBR); pg8::StaticOrder S; S.init(M, DM, G, bid);
          pg8::Gemm g{(const bf16_t*)(ws + WS_YB), wb + (size_t)DM * DSSM, M, DM, DATT}; pg8::EpiBranch<1> E{(const bf16_t*)(ws + WS_GATE), (float*)(ws + WS_MF), (bf16_t*)(ws + WS_MB)}; pg8::gemm_phase(lds, g, S, E); }
        { unsigned char* ws = ARG_WS(); const bf16_t* wb = (const bf16_t*)(ws + WS_WBR + (size_t)l * SZ_WBR); pg8::StaticOrder S; S.init(M, DM, G, bid);
          pg8::Gemm g{(const bf16_t*)(ws + WS_YC), wb + (size_t)DM * (DSSM + DATT), M, DM, DCONV}; pg8::EpiBranch<2> E{(const bf16_t*)(ws + WS_GATE), (float*)(ws + WS_MF), (bf16_t*)(ws + WS_MB)}; pg8::gemm_phase(lds, g, S, E); }
        GSYNC();
        { unsigned char* ws = ARG_WS(); pg8::Gemm g{(const bf16_t*)(ws + WS_MB), (const bf16_t*)(ws + WS_WOUT + (size_t)l * SZ_WOUT), M, DM, DM}; pg8::StaticOrder S; S.init(M, DM, G, bid);
          pg8::EpiResid<false> E{(const void*)(ws + WS_X), (bf16_t*)(ws + WS_X), 1.0f}; pg8::gemm_phase(lds, g, S, E); }
        GSYNC();
        for (int rep_ = 0; rep_ < REP_NORM; ++rep_) { IDS(); unsigned char* ws = ARG_WS(); norm_rows_b<false>((const bf16_t*)(ws + WS_X), ARG_IN(1) + (size_t)(l * 3 + 2) * DM, ws + WS_H, gw, NGW, lane); }
        GSYNC();
        { unsigned char* ws = ARG_WS(); pg8::Gemm g{(const bf16_t*)(ws + WS_H), (const bf16_t*)(ws + WS_W13T + (size_t)(l * 2 + 1) * SZ_W13T), M, 2 * DFF, DM}; pg8::StaticOrder S; S.init(M, 2 * DFF, G, bid);
          pg8::EpiSwiglu E{(bf16_t*)(ws + WS_ACT)}; pg8::gemm_phase(lds, g, S, E); }
        GSYNC();
        { unsigned char* ws = ARG_WS(); pg8::Gemm g{(const bf16_t*)(ws + WS_ACT), (const bf16_t*)(ws + WS_W2T + (size_t)(l * 2 + 1) * SZ_W2T), M, DM, DFF}; pg8::StaticOrder S; S.init(M, DM, G, bid);
          pg8::EpiResid<false> E{(const void*)(ws + WS_X), (bf16_t*)(ws + WS_X), 0.5f}; pg8::gemm_phase(lds, g, S, E); }
        GSYNC();
    }
    for (int rep_ = 0; rep_ < REP_NORM; ++rep_) { IDS(); unsigned char* ws = ARG_WS(); norm_rows_b<true>((const bf16_t*)(ws + WS_X), ARG_IN(22), ARG_OUT(), gw, NGW, lane); }
}

extern "C" void kernel_launch(void* const* d_in, const int* in_sizes, int n_in, void* d_out, int out_size, void* d_ws, size_t ws_size, hipStream_t stream) {
    static int grid_blocks = 0;
    if (!grid_blocks) {
        if (n_in != 23 || out_size != M * DM || ws_size < WS_END) { fprintf(stderr, "kernel_launch: unexpected problem (n_in %d out %d ws %zu need %zu)\n", n_in, out_size, ws_size, (size_t)WS_END); grid_blocks = -1; return; }
        int dev = 0, cus = 0, per_cu = 0;
        (void)hipGetDevice(&dev);
        (void)hipDeviceGetAttribute(&cus, hipDeviceAttributeMultiprocessorCount, dev);
        (void)hipFuncSetAttribute((const void*)fwd_megakernel, hipFuncAttributeMaxDynamicSharedMemorySize, LDS_BYTES);
        (void)hipOccupancyMaxActiveBlocksPerMultiprocessor(&per_cu, (const void*)fwd_megakernel, 512, LDS_BYTES);
        if (per_cu < 1) per_cu = 1;
        grid_blocks = cus * per_cu;
    }
    if (grid_blocks < 0) return;
    Params p{};
    for (int i = 0; i < 23; ++i) p.in[i] = (const float*)d_in[i];
    p.out = (float*)d_out; p.ws = (unsigned char*)d_ws;
    void* args[] = {&p};
    hipError_t e = hipLaunchCooperativeKernel((void*)fwd_megakernel, dim3(grid_blocks), dim3(512), args, LDS_BYTES, stream);
    if (e != hipSuccess) fprintf(stderr, "cooperative launch failed: %s (grid %d)\n", hipGetErrorString(e), grid_blocks);
}
```

```cpp
#include <hip/hip_runtime.h>
#include <hip/hip_cooperative_groups.h>
#include <cstdio>
#include <cmath>
namespace cg = cooperative_groups;

#define LAS __attribute__((address_space(3)))
#define DI __device__ __forceinline__
typedef unsigned short bf16_t;
typedef short bf16x8 __attribute__((ext_vector_type(8)));
typedef short s16x4 __attribute__((ext_vector_type(4)));
typedef float f32x4 __attribute__((ext_vector_type(4)));
typedef float f32x16 __attribute__((ext_vector_type(16)));
typedef unsigned u32x4 __attribute__((ext_vector_type(4)));
typedef unsigned u32x2 __attribute__((ext_vector_type(2)));

constexpr int SEQ = 4096, M = 8192, DM = 2048, DFF = 5504, DSSM = 512, DATT = 1024, DCONV = 512, DIN = 5120, NGATE = 6144, NCOMB = DIN + NGATE, DEPTH = 2;
constexpr int LDS_BYTES = 147456, LDS_MISC = 147456 - 64;
constexpr float C2 = 0.125f * 1.4426950408889634f;

constexpr size_t al256(size_t x) { return (x + 255) & ~(size_t)255; }
constexpr size_t SZ_W13T = (size_t)2 * DFF * DM * 2, SZ_W2T = (size_t)DM * DFF * 2, SZ_WCOMB = (size_t)NCOMB * DM * 2, SZ_WGLU = (size_t)DSSM * DSSM * 2;
constexpr size_t SZ_WBR = (size_t)DM * DM * 2, SZ_WOUT = (size_t)DM * DM * 2;
constexpr size_t WS_W13T = 0;
constexpr size_t WS_W2T = WS_W13T + 4 * SZ_W13T;
constexpr size_t WS_WCOMB = WS_W2T + 4 * SZ_W2T;
constexpr size_t WS_WGLU = WS_WCOMB + 2 * SZ_WCOMB;
constexpr size_t WS_WBR = WS_WGLU + 2 * SZ_WGLU;
constexpr size_t WS_WOUT = WS_WBR + 2 * SZ_WBR;
constexpr size_t WS_ROPE = WS_WOUT + 2 * SZ_WOUT;
constexpr size_t WS_X = WS_ROPE + (size_t)2 * SEQ * 32 * 4;
constexpr size_t WS_H = WS_X + (size_t)M * DM * 4;
constexpr size_t WS_ACT = WS_H + (size_t)M * DM * 2;
constexpr size_t WS_U = WS_ACT + (size_t)M * DFF * 2;
constexpr size_t WS_Q = WS_U + (size_t)M * DSSM * 4;
constexpr size_t WS_K = WS_Q + (size_t)M * DATT * 2;
constexpr size_t WS_V = WS_K + (size_t)M * DATT * 2;
constexpr size_t WS_BG = WS_V + (size_t)M * DATT * 2;
constexpr size_t WS_CG = WS_BG + (size_t)M * DCONV * 2;
constexpr size_t WS_XV = WS_CG + (size_t)M * DCONV * 2;
constexpr size_t WS_GATE = WS_XV + (size_t)M * DCONV * 2;
constexpr size_t WS_YG = WS_GATE + (size_t)M * NGATE * 2;
constexpr size_t WS_YA = WS_YG + (size_t)M * DSSM * 2;
constexpr size_t WS_YB = WS_YA + (size_t)M * DSSM * 2;
constexpr size_t WS_YC = WS_YB + (size_t)M * DATT * 2;
constexpr size_t WS_MF = WS_YC + (size_t)M * DCONV * 2;
constexpr size_t WS_MB = WS_MF + (size_t)M * DM * 4;
constexpr size_t WS_SE = WS_MB + (size_t)M * DM * 2;
constexpr size_t WS_BAR = WS_SE + (size_t)4096 * 256 * 4;
constexpr size_t WS_END = WS_BAR + 16384;

typedef float f32x2_t __attribute__((ext_vector_type(2))); typedef __bf16 bf16x2_t __attribute__((ext_vector_type(2)));
DI unsigned pk2(float lo, float hi) { f32x2_t v = {lo, hi}; bf16x2_t b = __builtin_convertvector(v, bf16x2_t); return __builtin_bit_cast(unsigned, b); }
DI float bflo(unsigned w) { return __uint_as_float(w << 16); }
DI float bfhi(unsigned w) { return __uint_as_float(w & 0xffff0000u); }
DI float wave_sum(float v) {
#pragma unroll
    for (int o = 1; o < 64; o <<= 1) v += __shfl_xor(v, o);
    return v;
}
DI float sigmoidf_(float x) { return __builtin_amdgcn_rcpf(1.0f + __builtin_amdgcn_exp2f(-1.4426950408889634f * x)); }
DI float siluf_(float x) { return x * sigmoidf_(x); }
DI float gelu_tanh(float y) { const float z = 0.7978845608028654f * (y + 0.044715f * y * y * y); const float t = 1.0f - 2.0f / (1.0f + __expf(2.0f * z)); return 0.5f * y * (1.0f + t); }
#define LDS_WAIT() asm volatile("s_waitcnt lgkmcnt(0)" ::: "memory")

namespace pg8 {
constexpr int BM = 256, BK = 64, HALF = 128, HTB = HALF * BK * 2, STAGE_BYTES = 8 * HTB, NXCD = 8, WGM = 8;
DI int lds_byte(int r, int c) { const int st = (r >> 4) * 2 + (c >> 5), rr = r & 15, cc = c & 31, ob = rr * 64 + cc * 2; return st * 1024 + (ob ^ (((ob >> 9) & 1) << 5)); }
DI void stage_rc(int b, int& R, int& C) { const int st = b / 1024, sb = b % 1024, swz = sb ^ (((sb >> 9) & 1) << 5); R = (st >> 1) * 16 + swz / 64; C = (st & 1) * 32 + (swz % 64) / 2; }
DI int perm32(int rho) { const int n = rho >> 4, i = rho & 15; return 8 * (i >> 2) + 4 * n + (i & 3); }
struct Unit { int pm, pn; };
struct Gemm { const bf16_t* A; const bf16_t* Bt; int M, N, K; };
struct StaticOrder {
    int nM, nN, nwg, G, c;
    DI void init(int M_, int N_, int G_, int c_) { nM = M_ / BM; nN = N_ / BM; nwg = nM * nN; G = G_; c = c_; }
    DI bool next(int i, Unit& u) const {
        const long L = (long)i * G + c; if (L >= nwg) return false;
        int wgid = (int)L; { const int q = nwg / NXCD, r = nwg % NXCD, xcd = wgid % NXCD, off = wgid / NXCD; wgid = (xcd < r ? xcd * (q + 1) : r * (q + 1) + (xcd - r) * q) + off; }
        const int nig = WGM * nN, gid = wgid / nig, fm = gid * WGM, gsz = (nM - fm) < WGM ? (nM - fm) : WGM;
        u.pm = fm + ((wgid % nig) % gsz); u.pn = (wgid % nig) / gsz; return true;
    }
};
template <class Epi, bool ALIGN_EPI = true, bool SP2 = true>
DI void gemm_phase(LAS unsigned char* lds, const Gemm g, const StaticOrder& S, const Epi& E) {
    int tid_ = threadIdx.x; asm volatile("" : "+v"(tid_));
    const int tid = tid_, wid = __builtin_amdgcn_readfirstlane(tid >> 6), lane = tid & 63, wr = wid >> 2, wc = wid & 3, fr = lane & 15, fq = lane >> 4;
    const int K = g.K, nt = K / BK;
    unsigned voffA[2], voffB[2];
#pragma unroll
    for (int i = 0; i < 2; ++i) { int R, C; stage_rc(tid * 16 + i * 8192, R, C); const int Rb = Epi::PERM ? ((R & ~31) + perm32(R & 31)) : R;
        voffA[i] = (unsigned)(R * K + C) * 2u; voffB[i] = (unsigned)(Rb * K + C) * 2u; }
    const size_t kstep = (size_t)(BK * 2);
    const size_t hstep = (size_t)HALF * K * 2;
    const size_t tstep = 2 * hstep;
    const unsigned ldsw = (unsigned)wid * 1024u;
    const int aoff = lds_byte(wr * 64 + fr, fq * 8), boff = lds_byte(wc * 32 + fr, fq * 8);
#define PG8_SA(b, h) (((b) * 2 + (h)) * HTB)
#define PG8_SB(b, h) ((4 + (b) * 2 + (h)) * HTB)
#define PG8_STAGE(bufoff, gbase, voff) do { _Pragma("unroll") for (int _i = 0; _i < 2; ++_i) \
        __builtin_amdgcn_global_load_lds((const unsigned*)((const char*)(gbase) + (voff)[_i]), (LAS unsigned*)(lds + (bufoff) + ldsw + _i * 8192), 16, 0, 0); } while (0)
#define PG8_LDA(dst, b, h) do { _Pragma("unroll") for (int m = 0; m < 4; ++m) _Pragma("unroll") for (int k = 0; k < 2; ++k) dst[m][k] = *(const LAS bf16x8*)(lds + PG8_SA(b, h) + aoff + m * 2048 + k * 1024); } while (0)
#define PG8_LDB(dst, b, h) do { _Pragma("unroll") for (int n = 0; n < 2; ++n) _Pragma("unroll") for (int k = 0; k < 2; ++k) dst[n][k] = *(const LAS bf16x8*)(lds + PG8_SB(b, h) + boff + n * 2048 + k * 1024); } while (0)
#define PG8_MMA(ai, bj, At, Bt) do { __builtin_amdgcn_s_setprio(1); _Pragma("unroll") for (int m = 0; m < 4; ++m) _Pragma("unroll") for (int n = 0; n < 2; ++n) _Pragma("unroll") for (int k = 0; k < 2; ++k) \
        acc[ai][bj][m][n] = __builtin_amdgcn_mfma_f32_16x16x32_bf16(Bt[n][k], At[m][k], acc[ai][bj][m][n], 0, 0, 0); __builtin_amdgcn_s_setprio(0); } while (0)
#define PG8_WAIT_V(n) asm volatile("s_waitcnt vmcnt(" #n ")" ::: "memory")
#define PG8_WAIT_L(n) asm volatile("s_waitcnt lgkmcnt(" #n ")" ::: "memory")
#define PG8_BAR __builtin_amdgcn_s_barrier()
#define PG8_SCHED __builtin_amdgcn_sched_barrier(0)
    Unit cur, nxt; int ui = 0;
    if (!S.next(0, cur)) return;
    f32x4 acc[2][2][4][2];
#pragma unroll
    for (int a = 0; a < 2; ++a)
#pragma unroll
        for (int b = 0; b < 2; ++b)
#pragma unroll
            for (int m = 0; m < 4; ++m)
#pragma unroll
                for (int n = 0; n < 2; ++n) acc[a][b][m][n] = (f32x4){0.f, 0.f, 0.f, 0.f};
    bf16x8 At[4][2], B0[2][2], B1[2][2];
    const char* cA = (const char*)g.A + (size_t)cur.pm * tstep; const char* cB = (const char*)g.Bt + (size_t)cur.pn * tstep;
    if constexpr (SP2) {
        PG8_STAGE(PG8_SB(0, 0), cB, voffB); PG8_STAGE(PG8_SB(0, 1), cB + hstep, voffB); PG8_STAGE(PG8_SA(0, 0), cA, voffA); PG8_STAGE(PG8_SA(0, 1), cA + hstep, voffA);
        if (wr == 1) PG8_BAR;
        PG8_WAIT_V(2); PG8_BAR;
        PG8_STAGE(PG8_SB(1, 0), cB + kstep, voffB); PG8_STAGE(PG8_SA(1, 0), cA + kstep, voffA); PG8_STAGE(PG8_SB(1, 1), cB + hstep + kstep, voffB);
        PG8_WAIT_V(6); PG8_BAR;
    } else {
        PG8_STAGE(PG8_SB(0, 0), cB, voffB); PG8_STAGE(PG8_SA(0, 0), cA, voffA); PG8_STAGE(PG8_SB(0, 1), cB + hstep, voffB); PG8_STAGE(PG8_SA(0, 1), cA + hstep, voffA);
        if (wr == 1) PG8_BAR;
        PG8_WAIT_V(4); PG8_BAR;
        PG8_STAGE(PG8_SB(1, 0), cB + kstep, voffB); PG8_STAGE(PG8_SA(1, 0), cA + kstep, voffA); PG8_STAGE(PG8_SB(1, 1), cB + hstep + kstep, voffB);
        PG8_WAIT_V(6); PG8_BAR;
    }
    for (;;) {
        const bool has_next = S.next(ui + 1, nxt);
        const char* nA = has_next ? (const char*)g.A + (size_t)nxt.pm * tstep : cA; const char* nB = has_next ? (const char*)g.Bt + (size_t)nxt.pn * tstep : cB;
        for (int t = 0; t < nt; t += 2) {
            const bool last = (t == nt - 2);
            const char* a1 = cA + (size_t)(t + 1) * kstep;
            const char* a2 = last ? nA : cA + (size_t)(t + 2) * kstep; const char* b2 = last ? nB : cB + (size_t)(t + 2) * kstep;
            const char* a3 = a2 + kstep; const char* b3 = b2 + kstep;
            if constexpr (SP2) {
            PG8_LDB(B0, 0, 0); PG8_LDB(B1, 0, 1); PG8_SCHED; PG8_LDA(At, 0, 0); PG8_STAGE(PG8_SA(1, 1), a1 + hstep, voffA);
            PG8_WAIT_V(8); PG8_WAIT_L(0); PG8_BAR; PG8_MMA(0, 0, At, B0); PG8_MMA(0, 1, At, B1); PG8_BAR; PG8_SCHED;
            PG8_LDA(At, 0, 1); PG8_STAGE(PG8_SB(0, 0), b2, voffB); PG8_STAGE(PG8_SB(0, 1), b2 + hstep, voffB); PG8_STAGE(PG8_SA(0, 0), a2, voffA);
            PG8_WAIT_V(8); PG8_WAIT_L(0); PG8_BAR; PG8_MMA(1, 0, At, B0); PG8_MMA(1, 1, At, B1); PG8_BAR; PG8_SCHED;
            PG8_LDB(B0, 1, 0); PG8_LDB(B1, 1, 1); PG8_SCHED; PG8_LDA(At, 1, 0); PG8_STAGE(PG8_SA(0, 1), a2 + hstep, voffA);
            PG8_WAIT_V(8); PG8_WAIT_L(0); PG8_BAR; PG8_MMA(0, 0, At, B0); PG8_MMA(0, 1, At, B1); PG8_BAR; PG8_SCHED;
            PG8_LDA(At, 1, 1); PG8_STAGE(PG8_SB(1, 0), b3, voffB); PG8_STAGE(PG8_SB(1, 1), b3 + hstep, voffB); PG8_STAGE(PG8_SA(1, 0), a3, voffA);
            PG8_WAIT_V(8); PG8_WAIT_L(0); PG8_BAR; PG8_MMA(1, 0, At, B0); PG8_MMA(1, 1, At, B1); PG8_BAR; PG8_SCHED;
            } else {
            PG8_LDB(B0, 0, 0); PG8_SCHED; PG8_LDA(At, 0, 0); PG8_STAGE(PG8_SA(1, 1), a1 + hstep, voffA);
            PG8_WAIT_L(8); PG8_BAR; PG8_WAIT_L(0); PG8_MMA(0, 0, At, B0); PG8_BAR; PG8_SCHED;
            PG8_LDB(B1, 0, 1); PG8_STAGE(PG8_SB(0, 0), b2, voffB);
            PG8_BAR; PG8_WAIT_L(0); PG8_MMA(0, 1, At, B1); PG8_BAR;
            PG8_LDA(At, 0, 1); PG8_STAGE(PG8_SA(0, 0), a2, voffA);
            PG8_BAR; PG8_WAIT_L(0); PG8_MMA(1, 0, At, B0); PG8_BAR; PG8_SCHED;
            PG8_STAGE(PG8_SB(0, 1), b2 + hstep, voffB);
            PG8_WAIT_V(6); PG8_BAR; PG8_MMA(1, 1, At, B1); PG8_BAR;
            PG8_LDB(B0, 1, 0); PG8_SCHED; PG8_LDA(At, 1, 0); PG8_STAGE(PG8_SA(0, 1), a2 + hstep, voffA);
            PG8_WAIT_L(8); PG8_BAR; PG8_WAIT_L(0); PG8_MMA(0, 0, At, B0); PG8_BAR; PG8_SCHED;
            PG8_LDB(B1, 1, 1); PG8_STAGE(PG8_SB(1, 0), b3, voffB);
            PG8_BAR; PG8_WAIT_L(0); PG8_MMA(0, 1, At, B1); PG8_BAR;
            PG8_LDA(At, 1, 1); PG8_STAGE(PG8_SA(1, 0), a3, voffA);
            PG8_BAR; PG8_WAIT_L(0); PG8_MMA(1, 0, At, B0); PG8_BAR; PG8_SCHED;
            PG8_STAGE(PG8_SB(1, 1), b3 + hstep, voffB);
            PG8_WAIT_V(6); PG8_BAR; PG8_MMA(1, 1, At, B1); PG8_BAR;
            }
        }
        if constexpr (ALIGN_EPI) { if (wr == 0) PG8_BAR; }
        E(acc, cur, wr, wc, fr, fq);
        if (!has_next) break;
#pragma unroll
        for (int a = 0; a < 2; ++a)
#pragma unroll
            for (int b = 0; b < 2; ++b)
#pragma unroll
                for (int m = 0; m < 4; ++m)
#pragma unroll
                    for (int n = 0; n < 2; ++n) acc[a][b][m][n] = (f32x4){0.f, 0.f, 0.f, 0.f};
        cur = nxt; cA = nA; cB = nB; ++ui;
        if constexpr (ALIGN_EPI) { if (wr == 1) PG8_BAR; }
    }
    PG8_WAIT_V(0);
    if constexpr (!ALIGN_EPI) { if (wr == 0) PG8_BAR; }
    PG8_BAR;
#undef PG8_SA
#undef PG8_SB
#undef PG8_STAGE
#undef PG8_LDA
#undef PG8_LDB
#undef PG8_MMA
#undef PG8_WAIT_V
#undef PG8_WAIT_L
#undef PG8_BAR
#undef PG8_SCHED
}
typedef f32x4 Acc[2][2][4][2];

struct EpiSwiglu {
    static constexpr bool PERM = true; bf16_t* O;
    DI void operator()(const Acc& acc, const Unit& u, int wr, int wc, int fr, int fq) const {
        const int row0 = u.pm * BM + wr * 64 + fr, col0 = u.pn * 128 + wc * 32 + 8 * fq;
#pragma unroll
        for (int ai = 0; ai < 2; ++ai)
#pragma unroll
            for (int m = 0; m < 4; ++m) {
                bf16_t* rowp = O + (size_t)(row0 + ai * HALF + m * 16) * DFF + col0;
                const f32x4 a0 = acc[ai][0][m][0], a1 = acc[ai][0][m][1], b0 = acc[ai][1][m][0], b1 = acc[ai][1][m][1];
                float v[8];
#pragma unroll
                for (int e = 0; e < 4; ++e) { v[e] = siluf_(a0[e]) * b0[e]; v[4 + e] = siluf_(a1[e]) * b1[e]; }
                u32x4 w; w.x = pk2(v[0], v[1]); w.y = pk2(v[2], v[3]); w.z = pk2(v[4], v[5]); w.w = pk2(v[6], v[7]);
                *(u32x4*)rowp = w;
            }
    }
};
template <bool SRC_F32> struct EpiResid {
    static constexpr bool PERM = true; const void* src; bf16_t* dst; float scale;
    struct Grp { f32x4 f[4]; u32x4 h[2]; };
    DI void operator()(const Acc& acc, const Unit& u, int wr, int wc, int fr, int fq) const {
        const int row0 = u.pm * BM + wr * 64 + fr, col0 = u.pn * BM + wc * 32 + 8 * fq;
        Grp cur, nxt;
#define ER_LOAD(dstv, g) do { const size_t off_ = (size_t)(row0 + ((g) >> 2) * HALF + ((g) & 3) * 16) * DM + col0; \
        _Pragma("unroll") for (int bj_ = 0; bj_ < 2; ++bj_) { if (SRC_F32) { dstv.f[2 * bj_] = *(const f32x4*)((const float*)src + off_ + bj_ * HALF); dstv.f[2 * bj_ + 1] = *(const f32x4*)((const float*)src + off_ + bj_ * HALF + 4); } \
            else dstv.h[bj_] = *(const u32x4*)((const bf16_t*)src + off_ + bj_ * HALF); } } while (0)
        ER_LOAD(cur, 0);
#pragma unroll
        for (int g = 0; g < 8; ++g) {
            if (g < 7) ER_LOAD(nxt, g + 1);
            const size_t off = (size_t)(row0 + (g >> 2) * HALF + (g & 3) * 16) * DM + col0;
#pragma unroll
            for (int bj = 0; bj < 2; ++bj) { f32x4 s0, s1;
                if (SRC_F32) { s0 = cur.f[2 * bj]; s1 = cur.f[2 * bj + 1]; }
                else { const u32x4 hw = cur.h[bj]; s0 = (f32x4){bflo(hw.x), bfhi(hw.x), bflo(hw.y), bfhi(hw.y)}; s1 = (f32x4){bflo(hw.z), bfhi(hw.z), bflo(hw.w), bfhi(hw.w)}; }
                const f32x4 v0 = s0 + acc[g >> 2][bj][g & 3][0] * scale, v1 = s1 + acc[g >> 2][bj][g & 3][1] * scale;
                u32x4 w; w.x = pk2(v0[0], v0[1]); w.y = pk2(v0[2], v0[3]); w.z = pk2(v1[0], v1[1]); w.w = pk2(v1[2], v1[3]);
                *(u32x4*)(dst + off + bj * HALF) = w; }
            cur = nxt;
        }
#undef ER_LOAD
    }
};
struct EpiInGate {
    static constexpr bool PERM = true;
    unsigned char* ws; const float* bgate;
    DI void operator()(const Acc& acc, const Unit& u, int wr, int wc, int fr, int fq) const {
        const int pn = u.pn, row0 = u.pm * BM + wr * 64 + fr, cl0 = wc * 32 + 8 * fq;
        float* U = (float*)(ws + WS_U); bf16_t* GATE = (bf16_t*)(ws + WS_GATE); const float* COS = (const float*)(ws + WS_ROPE); const float* SIN = COS + SEQ * 32;
        if (pn < 2) {
#pragma unroll
            for (int ai = 0; ai < 2; ++ai)
#pragma unroll
                for (int m = 0; m < 4; ++m) { bf16_t* rowp = (bf16_t*)U + (size_t)(row0 + ai * HALF + m * 16) * DSSM + pn * 256 + cl0;
#pragma unroll
                    for (int bj = 0; bj < 2; ++bj) { const f32x4 v0 = acc[ai][bj][m][0], v1 = acc[ai][bj][m][1];
                        u32x4 w; w.x = pk2(v0[0], v0[1]); w.y = pk2(v0[2], v0[3]); w.z = pk2(v1[0], v1[1]); w.w = pk2(v1[2], v1[3]); *(u32x4*)(rowp + bj * HALF) = w; } }
        } else if (pn < 10) {
            const bool isq = pn < 6; const int tq = isq ? pn - 2 : pn - 6; bf16_t* dst = (bf16_t*)(ws + (isq ? WS_Q : WS_K)); const float sc = isq ? C2 : 1.0f;
            const int hc = 4 * tq + wc, d0 = 8 * fq;
#pragma unroll
            for (int ai = 0; ai < 2; ++ai)
#pragma unroll
                for (int m = 0; m < 4; ++m) { const int row = row0 + ai * HALF + m * 16, pos = row & (SEQ - 1);
                    const f32x4 c0 = *(const f32x4*)(COS + pos * 32 + d0), c1 = *(const f32x4*)(COS + pos * 32 + d0 + 4);
                    const f32x4 s0 = *(const f32x4*)(SIN + pos * 32 + d0), s1 = *(const f32x4*)(SIN + pos * 32 + d0 + 4);
                    const f32x4 x10 = acc[ai][0][m][0], x11 = acc[ai][0][m][1], x20 = acc[ai][1][m][0], x21 = acc[ai][1][m][1];
                    const f32x4 o10 = (x10 * c0 - x20 * s0) * sc, o11 = (x11 * c1 - x21 * s1) * sc, o20 = (x20 * c0 + x10 * s0) * sc, o21 = (x21 * c1 + x11 * s1) * sc;
                    bf16_t* rp = dst + (size_t)row * DATT + hc * 64 + d0;
                    u32x4 w; w.x = pk2(o10[0], o10[1]); w.y = pk2(o10[2], o10[3]); w.z = pk2(o11[0], o11[1]); w.w = pk2(o11[2], o11[3]); *(u32x4*)rp = w;
                    w.x = pk2(o20[0], o20[1]); w.y = pk2(o20[2], o20[3]); w.z = pk2(o21[0], o21[1]); w.w = pk2(o21[2], o21[3]); *(u32x4*)(rp + 32) = w; }
        } else if (pn < 20) {
            bf16_t* dst; int pitch, colt;
            if (pn < 14) { dst = (bf16_t*)(ws + WS_V); pitch = DATT; colt = (pn - 10) * 256; }
            else { const int which = (pn - 14) >> 1; dst = (bf16_t*)(ws + WS_BG + (size_t)which * (WS_CG - WS_BG)); pitch = DCONV; colt = ((pn - 14) & 1) * 256; }
#pragma unroll
            for (int ai = 0; ai < 2; ++ai)
#pragma unroll
                for (int m = 0; m < 4; ++m) { bf16_t* rp = dst + (size_t)(row0 + ai * HALF + m * 16) * pitch + colt + cl0;
#pragma unroll
                    for (int bj = 0; bj < 2; ++bj) { const f32x4 v0 = acc[ai][bj][m][0], v1 = acc[ai][bj][m][1];
                        u32x4 w; w.x = pk2(v0[0], v0[1]); w.y = pk2(v0[2], v0[3]); w.z = pk2(v1[0], v1[1]); w.w = pk2(v1[2], v1[3]); *(u32x4*)(rp + bj * HALF) = w; } }
        } else {
            const int gc0 = (pn - 20) * 256 + cl0;
            f32x4 bv[2][2];
#pragma unroll
            for (int bj = 0; bj < 2; ++bj)
#pragma unroll
                for (int n = 0; n < 2; ++n) bv[bj][n] = *(const f32x4*)(bgate + gc0 + bj * HALF + 4 * n);
#pragma unroll
            for (int ai = 0; ai < 2; ++ai)
#pragma unroll
                for (int m = 0; m < 4; ++m) { unsigned char* rp = (unsigned char*)GATE + (size_t)(row0 + ai * HALF + m * 16) * NGATE + gc0;
#pragma unroll
                    for (int bj = 0; bj < 2; ++bj) { const f32x4 v0 = acc[ai][bj][m][0] + bv[bj][0], v1 = acc[ai][bj][m][1] + bv[bj][1];
                        u32x2 w;
                        w.x = (unsigned)(sigmoidf_(v0[0]) * 255.0f + 0.5f) | ((unsigned)(sigmoidf_(v0[1]) * 255.0f + 0.5f) << 8) | ((unsigned)(sigmoidf_(v0[2]) * 255.0f + 0.5f) << 16) | ((unsigned)(sigmoidf_(v0[3]) * 255.0f + 0.5f) << 24);
                        w.y = (unsigned)(sigmoidf_(v1[0]) * 255.0f + 0.5f) | ((unsigned)(sigmoidf_(v1[1]) * 255.0f + 0.5f) << 8) | ((unsigned)(sigmoidf_(v1[2]) * 255.0f + 0.5f) << 16) | ((unsigned)(sigmoidf_(v1[3]) * 255.0f + 0.5f) << 24);
                        *(u32x2*)(rp + bj * HALF) = w; } }
        }
    }
};
struct EpiGLU {
    static constexpr bool PERM = true; const bf16_t* YG; bf16_t* YA; const float* bias;
    DI void operator()(const Acc& acc, const Unit& u, int wr, int wc, int fr, int fq) const {
        const int row0 = u.pm * BM + wr * 64 + fr, col0 = u.pn * BM + wc * 32 + 8 * fq;
        f32x4 bv[2][2];
#pragma unroll
        for (int bj = 0; bj < 2; ++bj) { bv[bj][0] = *(const f32x4*)(bias + col0 + bj * HALF); bv[bj][1] = *(const f32x4*)(bias + col0 + bj * HALF + 4); }
        u32x4 cur[2], nxt[2];
#define EG_LOAD(dstv, g) do { const size_t off_ = (size_t)(row0 + ((g) >> 2) * HALF + ((g) & 3) * 16) * DSSM + col0; dstv[0] = *(const u32x4*)(YG + off_); dstv[1] = *(const u32x4*)(YG + off_ + HALF); } while (0)
        EG_LOAD(cur, 0);
#pragma unroll
        for (int g = 0; g < 8; ++g) {
            if (g < 7) EG_LOAD(nxt, g + 1);
            const size_t off = (size_t)(row0 + (g >> 2) * HALF + (g & 3) * 16) * DSSM + col0;
#pragma unroll
            for (int bj = 0; bj < 2; ++bj) { const u32x4 y = cur[bj];
                const f32x4 v0 = acc[g >> 2][bj][g & 3][0] + bv[bj][0], v1 = acc[g >> 2][bj][g & 3][1] + bv[bj][1];
                u32x4 w; w.x = pk2(bflo(y.x) * sigmoidf_(v0[0]), bfhi(y.x) * sigmoidf_(v0[1])); w.y = pk2(bflo(y.y) * sigmoidf_(v0[2]), bfhi(y.y) * sigmoidf_(v0[3]));
                w.z = pk2(bflo(y.z) * sigmoidf_(v1[0]), bfhi(y.z) * sigmoidf_(v1[1])); w.w = pk2(bflo(y.w) * sigmoidf_(v1[2]), bfhi(y.w) * sigmoidf_(v1[3]));
                *(u32x4*)(YA + off + bj * HALF) = w; }
            cur[0] = nxt[0]; cur[1] = nxt[1];
        }
#undef EG_LOAD
    }
};
template <int IDX> struct EpiBranch {
    static constexpr bool PERM = true; const bf16_t* GATE; float* MF; bf16_t* MB;
    DI void operator()(const Acc& acc, const Unit& u, int wr, int wc, int fr, int fq) const {
        const int row0 = u.pm * BM + wr * 64 + fr, col0 = u.pn * BM + wc * 32 + 8 * fq;
        u32x2 gcur[2], gnxt[2]; u32x4 mcur[2], mnxt[2];
#define EB_LOAD(gd, md, g) do { const int row_ = row0 + ((g) >> 2) * HALF + ((g) & 3) * 16; \
        _Pragma("unroll") for (int bj_ = 0; bj_ < 2; ++bj_) { gd[bj_] = *(const u32x2*)((const unsigned char*)GATE + (size_t)row_ * NGATE + IDX * DM + col0 + bj_ * HALF); \
            if (IDX > 0) md[bj_] = *(const u32x4*)(MB + (size_t)row_ * DM + col0 + bj_ * HALF); } } while (0)
        EB_LOAD(gcur, mcur, 0);
#pragma unroll
        for (int g = 0; g < 8; ++g) {
            if (g < 7) EB_LOAD(gnxt, mnxt, g + 1);
            const int row = row0 + (g >> 2) * HALF + (g & 3) * 16;
#pragma unroll
            for (int bj = 0; bj < 2; ++bj) { const int col = col0 + bj * HALF; const u32x2 gw = gcur[bj]; constexpr float I255 = 1.0f / 255.0f;
                f32x4 v0 = acc[g >> 2][bj][g & 3][0] * I255, v1 = acc[g >> 2][bj][g & 3][1] * I255;
                v0[0] *= (float)(gw.x & 255u); v0[1] *= (float)((gw.x >> 8) & 255u); v0[2] *= (float)((gw.x >> 16) & 255u); v0[3] *= (float)(gw.x >> 24);
                v1[0] *= (float)(gw.y & 255u); v1[1] *= (float)((gw.y >> 8) & 255u); v1[2] *= (float)((gw.y >> 16) & 255u); v1[3] *= (float)(gw.y >> 24);
                if (IDX > 0) { const u32x4 pm_ = mcur[bj];
                    v0[0] += bflo(pm_.x); v0[1] += bfhi(pm_.x); v0[2] += bflo(pm_.y); v0[3] += bfhi(pm_.y);
                    v1[0] += bflo(pm_.z); v1[1] += bfhi(pm_.z); v1[2] += bflo(pm_.w); v1[3] += bfhi(pm_.w); }
                u32x4 w; w.x = pk2(v0[0], v0[1]); w.y = pk2(v0[2], v0[3]); w.z = pk2(v1[0], v1[1]); w.w = pk2(v1[2], v1[3]);
                *(u32x4*)(MB + (size_t)row * DM + col) = w; }
            gcur[0] = gnxt[0]; gcur[1] = gnxt[1];
            if (IDX > 0) { mcur[0] = mnxt[0]; mcur[1] = mnxt[1]; }
        }
#undef EB_LOAD
    }
};
}

DI void transpose_item(const float* W, int ldw, int K, bf16_t* WT, LAS float* scr, int k0, int nsrc0, int ndst0, int lane) {
#pragma unroll 8
    for (int i = 0; i < 32; ++i) { const int kk = 2 * i + (lane >> 5); scr[kk * 33 + (lane & 31)] = W[(size_t)(k0 + kk) * ldw + nsrc0 + (lane & 31)]; }
    LDS_WAIT();
    const int c = lane & 7;
#pragma unroll
    for (int j = 0; j < 4; ++j) { const int n = (lane >> 3) + 8 * j; const LAS float* s = scr + (8 * c) * 33 + n;
        u32x4 o; o.x = pk2(s[0 * 33], s[1 * 33]); o.y = pk2(s[2 * 33], s[3 * 33]); o.z = pk2(s[4 * 33], s[5 * 33]); o.w = pk2(s[6 * 33], s[7 * 33]);
        *(u32x4*)(WT + (size_t)(ndst0 + n) * K + k0 + 8 * c) = o; }
    LDS_WAIT();
}
DI void conv_matrix(const float* W, int ldw, int K, int Ndst, bf16_t* WT, int kind, int gw, int NGW, LAS float* scr, int lane) {
    const int nblk = Ndst / 32, nitems = (K / 64) * nblk;
    for (int it = gw; it < nitems; it += NGW) {
        const int kb = it / nblk, nb = it - kb * nblk, n = 32 * nb; int src = n;
        if (kind == 1) { const int pn = n >> 8, r = n & 255; src = (r < 128) ? 128 * pn + r : DFF + 128 * pn + (r - 128); }
        else if (kind == 2) { if (n >= 512 && n < 2560) { const int n1 = n - 512, t = n1 >> 8, r = n1 & 255, half = r >> 7, i = r & 127, hcl = i >> 5; src = 512 + 256 * t + 64 * hcl + 32 * half; } }
        transpose_item(W, ldw, K, WT, scr, 64 * kb, src, n, lane);
    }
}

template <bool OUT_F32>
DI void norm_rows(const float* X, const float* g, void* out, int gw, int NGW, int lane) {
    for (int m = gw; m < M; m += NGW) {
        const f32x4* xr = (const f32x4*)(X + (size_t)m * DM) + lane;
        f32x4 v[8]; float s = 0.f;
#pragma unroll
        for (int j = 0; j < 8; ++j) { v[j] = xr[64 * j]; s += (v[j][0] * v[j][0] + v[j][1] * v[j][1]) + (v[j][2] * v[j][2] + v[j][3] * v[j][3]); }
        f32x4 gvv[8];
#pragma unroll
        for (int j = 0; j < 8; ++j) gvv[j] = ((const f32x4*)g)[64 * j + lane];
        const float r = 1.0f / sqrtf(wave_sum(s) * (1.0f / DM) + 1e-6f);
#pragma unroll
        for (int j = 0; j < 8; ++j) { const f32x4 o = v[j] * r * gvv[j];
            if (OUT_F32) ((f32x4*)((float*)out + (size_t)m * DM))[64 * j + lane] = o;
            else { u32x2 w; w.x = pk2(o[0], o[1]); w.y = pk2(o[2], o[3]); ((u32x2*)((bf16_t*)out + (size_t)m * DM))[64 * j + lane] = w; } }
    }
}

template <bool OUT_F32>
DI void norm_rows_b(const bf16_t* X, const float* g, void* out, int gw, int NGW, int lane) {
    for (int m = gw; m < M; m += NGW) {
        const u32x4* xr = (const u32x4*)(X + (size_t)m * DM) + lane;
        u32x4 w[4]; float s = 0.f;
#pragma unroll
        for (int j = 0; j < 4; ++j) w[j] = xr[64 * j];
        f32x4 gv[4][2];
#pragma unroll
        for (int j = 0; j < 4; ++j) { gv[j][0] = ((const f32x4*)g)[2 * (64 * j + lane)]; gv[j][1] = ((const f32x4*)g)[2 * (64 * j + lane) + 1]; }
        f32x4 v[4][2];
#pragma unroll
        for (int j = 0; j < 4; ++j) { v[j][0] = (f32x4){bflo(w[j].x), bfhi(w[j].x), bflo(w[j].y), bfhi(w[j].y)}; v[j][1] = (f32x4){bflo(w[j].z), bfhi(w[j].z), bflo(w[j].w), bfhi(w[j].w)};
#pragma unroll
            for (int q = 0; q < 2; ++q) s += (v[j][q][0] * v[j][q][0] + v[j][q][1] * v[j][q][1]) + (v[j][q][2] * v[j][q][2] + v[j][q][3] * v[j][q][3]); }
        const float r = 1.0f / sqrtf(wave_sum(s) * (1.0f / DM) + 1e-6f);
#pragma unroll
        for (int j = 0; j < 4; ++j) { const f32x4 o0 = v[j][0] * r * gv[j][0], o1 = v[j][1] * r * gv[j][1];
            if (OUT_F32) { f32x4* op = (f32x4*)((float*)out + (size_t)m * DM) + 2 * (64 * j + lane); op[0] = o0; op[1] = o1; }
            else { u32x4 ow; ow.x = pk2(o0[0], o0[1]); ow.y = pk2(o0[2], o0[3]); ow.z = pk2(o1[0], o1[1]); ow.w = pk2(o1[2], o1[3]); ((u32x4*)((bf16_t*)out + (size_t)m * DM))[64 * j + lane] = ow; } }
    }
}

constexpr int KP = 272, VP = 288, ATT_STAGE = 64 * KP + 64 * VP, ATT_X = 2 * ATT_STAGE;
static_assert(ATT_X + 65536 <= LDS_BYTES, "attention LDS");
#define MFMA32(a, b, c) __builtin_amdgcn_mfma_f32_32x32x16_bf16((a), (b), (c), 0, 0, 0)
typedef short v4i16_t __attribute__((ext_vector_type(4)));
DI s16x4 vtr(const LAS unsigned char* p) { return __builtin_bit_cast(s16x4, __builtin_amdgcn_ds_read_tr16_b64_v4i16((LAS v4i16_t*)p)); }

template <bool QK, bool PV>
DI void att_step(int t, LAS unsigned char* lds, const bf16_t* kg, const bf16_t* vg, int srow, int sch, int r, int h, int c, int voff0,
                 const bf16x8 (&qf)[4], f32x16 (&O)[4], bf16x8 (&pf)[4], float& mrun, float& lrun) {
    const LAS unsigned char* kbase = lds + (t & 1) * (64 * KP);
    const LAS unsigned char* vbase = lds + 2 * 64 * KP + ((t - 1) & 1) * (64 * VP);
    u32x4 kr[2], vr[2];
    const bool ldk = QK && (t + 1 < 64);
    if (ldk) {
#pragma unroll
        for (int i = 0; i < 2; ++i) kr[i] = *(const u32x4*)(kg + (size_t)((t + 1) * 64 + i * 32) * DATT);
    }
    if (QK) {
#pragma unroll
        for (int i = 0; i < 2; ++i) vr[i] = *(const u32x4*)(vg + (size_t)(t * 64 + i * 32) * DATT);
    }
    f32x16 S[2]; bf16x8 pfn[4]; s16x4 vA[4][2], vB[4][2];
#define VFRAG_LOAD(dstv, dt_) do { _Pragma("unroll") for (int kk_ = 0; kk_ < 4; ++kk_) { \
        const LAS unsigned char* vp_ = vbase + voff0 + (16 * kk_) * VP + 64 * (dt_); dstv[kk_][0] = vtr(vp_); dstv[kk_][1] = vtr(vp_ + 8 * VP); } } while (0)
#define PV_MMA(srcv, dt_) do { _Pragma("unroll") for (int kk_ = 0; kk_ < 4; ++kk_) { \
        const bf16x8 vf_ = __builtin_shufflevector(srcv[kk_][0], srcv[kk_][1], 0, 1, 2, 3, 4, 5, 6, 7); O[dt_] = MFMA32(vf_, pf[kk_], O[dt_]); } } while (0)
    if (QK) {
        bf16x8 kf[2][4];
#pragma unroll
        for (int kti = 0; kti < 2; ++kti)
#pragma unroll
            for (int ks = 0; ks < 4; ++ks) kf[kti][ks] = *(const LAS bf16x8*)(kbase + (32 * kti + r) * KP + c * 128 + (16 * ks + 8 * h) * 2);
        if (PV) VFRAG_LOAD(vA, 0);
        __builtin_amdgcn_sched_barrier(0);
#pragma unroll
        for (int kti = 0; kti < 2; ++kti)
#pragma unroll
            for (int ks = 0; ks < 4; ++ks) { if (ks == 0) { f32x16 z; _Pragma("unroll") for (int i = 0; i < 16; ++i) z[i] = 0.f; S[kti] = MFMA32(kf[kti][ks], qf[ks], z); } else S[kti] = MFMA32(kf[kti][ks], qf[ks], S[kti]); }
        float tm0 = fmaxf(fmaxf(S[0][0], S[0][1]), S[0][2]), tm1 = fmaxf(fmaxf(S[1][0], S[1][1]), S[1][2]);
#pragma unroll
        for (int i = 3; i < 15; i += 2) { tm0 = fmaxf(fmaxf(tm0, S[0][i]), S[0][i + 1]); tm1 = fmaxf(fmaxf(tm1, S[1][i]), S[1][i + 1]); }
        float tmax = fmaxf(fmaxf(tm0, tm1), fmaxf(S[0][15], S[1][15]));
        if (!PV || __builtin_amdgcn_ballot_w64(tmax > mrun + 8.0f) != 0ull) {
            tmax = fmaxf(tmax, __shfl_xor(tmax, 32));
            const float mnew = !PV ? tmax : fmaxf(tmax, mrun);
            const float alpha = !PV ? 1.0f : __builtin_amdgcn_exp2f(mrun - mnew);
            mrun = mnew; lrun *= alpha;
            if (PV) {
#pragma unroll
                for (int dt = 0; dt < 4; ++dt)
#pragma unroll
                    for (int i = 0; i < 16; ++i) O[dt][i] *= alpha;
#pragma unroll
                for (int kk = 0; kk < 4; ++kk) { u32x4 w = __builtin_bit_cast(u32x4, pf[kk]);
                    w.x = pk2(bflo(w.x) * alpha, bfhi(w.x) * alpha); w.y = pk2(bflo(w.y) * alpha, bfhi(w.y) * alpha); w.z = pk2(bflo(w.z) * alpha, bfhi(w.z) * alpha); w.w = pk2(bflo(w.w) * alpha, bfhi(w.w) * alpha);
                    pf[kk] = __builtin_bit_cast(bf16x8, w); }
            }
        }
        __builtin_amdgcn_sched_barrier(0);
    } else {
        VFRAG_LOAD(vA, 0);
    }
    if (PV) VFRAG_LOAD(vB, 1);
    if (QK) {
        f32x2_t ls2 = {0.f, 0.f};
#pragma unroll
        for (int kti = 0; kti < 2; ++kti)
#pragma unroll
            for (int i = 0; i < 16; i += 2) { f32x2_t p2; p2.x = __builtin_amdgcn_exp2f(S[kti][i] - mrun); p2.y = __builtin_amdgcn_exp2f(S[kti][i + 1] - mrun); S[kti][i] = p2.x; S[kti][i + 1] = p2.y; ls2 += p2; }
        lrun += ls2.x + ls2.y;
#pragma unroll
        for (int kk = 0; kk < 4; ++kk) { const int kti = kk >> 1, s = kk & 1; u32x4 w; w.x = pk2(S[kti][8 * s + 0], S[kti][8 * s + 1]); w.y = pk2(S[kti][8 * s + 2], S[kti][8 * s + 3]);
            w.z = pk2(S[kti][8 * s + 4], S[kti][8 * s + 5]); w.w = pk2(S[kti][8 * s + 6], S[kti][8 * s + 7]); pfn[kk] = __builtin_bit_cast(bf16x8, w); }
    }
    if (PV) {
        PV_MMA(vA, 0); VFRAG_LOAD(vA, 2); PV_MMA(vB, 1); VFRAG_LOAD(vB, 3); PV_MMA(vA, 2); PV_MMA(vB, 3);
    }
#ifdef ATT_INTERLEAVE
    if (QK && PV) {
        __builtin_amdgcn_sched_group_barrier(0x100, 8, 0);
#pragma unroll
        for (int gi = 0; gi < 16; ++gi) { __builtin_amdgcn_sched_group_barrier(0x008, 1, 0); __builtin_amdgcn_sched_group_barrier(0x402, 6, 0); if (gi == 1 || gi == 5) __builtin_amdgcn_sched_group_barrier(0x100, 8, 0); }
    }
#endif
    __builtin_amdgcn_sched_barrier(0);
    if (QK) {
#pragma unroll
        for (int kk = 0; kk < 4; ++kk) pf[kk] = pfn[kk];
        LAS unsigned char* nk = lds + ((t + 1) & 1) * (64 * KP); LAS unsigned char* nv = lds + 2 * 64 * KP + (t & 1) * (64 * VP);
        if (ldk) {
#pragma unroll
            for (int i = 0; i < 2; ++i) *(LAS u32x4*)(nk + (srow + 32 * i) * KP + sch * 16) = kr[i];
        }
#pragma unroll
        for (int i = 0; i < 2; ++i) *(LAS u32x4*)(nv + (srow + 32 * i) * VP + sch * 16) = vr[i];
    }
    __syncthreads();
#undef VFRAG_LOAD
#undef PV_MMA
}

DI void attn_phase(LAS unsigned char* lds, const bf16_t* Q, const bf16_t* K, const bf16_t* V, bf16_t* YB, const float* lamvec, const float* subln, float lambda_init, int vcu, int G) {
    int tid_ = threadIdx.x; asm volatile("" : "+v"(tid_));
    const int tid = tid_, lane = tid & 63, wave = __builtin_amdgcn_readfirstlane(tid >> 6), r = lane & 31, h = lane >> 5, qs = wave & 3, c = wave >> 2;
    const float lam = __expf(wave_sum(lamvec[lane] * lamvec[64 + lane])) - __expf(wave_sum(lamvec[128 + lane] * lamvec[192 + lane])) + lambda_init;
    const int srow = tid >> 4, sch = tid & 15;
    const int tq = (lane & 15) >> 2, tp = lane & 3, blk = (lane >> 4) & 1;
    for (int item = vcu; item < 512; item += G) {
        const int pair = item >> 5, qb = item & 31, b = pair >> 3, hd = pair & 7;
        const int rowq = b * SEQ + qb * 128 + qs * 32 + r;
        bf16x8 qf[4];
#pragma unroll
        for (int ks = 0; ks < 4; ++ks) qf[ks] = *(const bf16x8*)(Q + (size_t)rowq * DATT + hd * 128 + c * 64 + 16 * ks + 8 * h);
        f32x16 O[4];
#pragma unroll
        for (int dt = 0; dt < 4; ++dt)
#pragma unroll
            for (int i = 0; i < 16; ++i) O[dt][i] = 0.f;
        float mrun = 0.f, lrun = 0.f;
        const bf16_t* kg = K + (size_t)(b * SEQ + srow) * DATT + hd * 128 + sch * 8;
        const bf16_t* vg = V + (size_t)(b * SEQ + srow) * DATT + hd * 128 + sch * 8;
        u32x4 kr[2], vr[2];
#pragma unroll
        for (int i = 0; i < 2; ++i) kr[i] = *(const u32x4*)(kg + (size_t)(i * 32) * DATT);
#pragma unroll
        for (int i = 0; i < 2; ++i) *(LAS u32x4*)(lds + (srow + 32 * i) * KP + sch * 16) = kr[i];
        __syncthreads();
        bf16x8 pf[4];
#pragma unroll
        for (int i = 0; i < 4; ++i) pf[i] = (bf16x8){0, 0, 0, 0, 0, 0, 0, 0};
        const int voff0 = (4 * h + tq) * VP + (16 * blk) * 2 + 8 * tp;
        att_step<true, false>(0, lds, kg, vg, srow, sch, r, h, c, voff0, qf, O, pf, mrun, lrun);
        for (int t = 1; t < 64; ++t) att_step<true, true>(t, lds, kg, vg, srow, sch, r, h, c, voff0, qf, O, pf, mrun, lrun);
        att_step<false, true>(64, lds, kg, vg, srow, sch, r, h, c, voff0, qf, O, pf, mrun, lrun);
        const float ltot = lrun + __shfl_xor(lrun, 32), inv = 1.0f / ltot;
        LAS float* X = (LAS float*)(lds + ATT_X + qs * 16384);
        if (c == 1) { const float sc = lam * inv;
#pragma unroll
            for (int dt = 0; dt < 4; ++dt)
#pragma unroll
                for (int i = 0; i < 16; ++i) X[(dt * 16 + i) * 64 + lane] = O[dt][i] * sc; }
        __syncthreads();
        if (c == 0) {
            float ss = 0.f;
#pragma unroll
            for (int dt = 0; dt < 4; ++dt)
#pragma unroll
                for (int i = 0; i < 16; ++i) { const float o = O[dt][i] * inv - X[(dt * 16 + i) * 64 + lane]; O[dt][i] = o; ss += o * o; }
            ss += __shfl_xor(ss, 32);
            const float rn = (1.0f / sqrtf(ss * (1.0f / 128.0f) + 1e-6f)) * (1.0f - lambda_init);
            bf16_t* op = YB + (size_t)rowq * DATT + hd * 128;
#pragma unroll
            for (int dt = 0; dt < 4; ++dt)
#pragma unroll
                for (int g4 = 0; g4 < 4; ++g4) { const int d = 32 * dt + 8 * g4 + 4 * h; const f32x4 gv = *(const f32x4*)(subln + d);
                    u32x2 w; w.x = pk2(O[dt][4 * g4 + 0] * rn * gv[0], O[dt][4 * g4 + 1] * rn * gv[1]); w.y = pk2(O[dt][4 * g4 + 2] * rn * gv[2], O[dt][4 * g4 + 3] * rn * gv[3]);
                    *(u32x2*)(op + d) = w; }
        }
        __syncthreads();
    }
}

constexpr int S5_WAVE_LDS = 12800, S5_SP = 132;
struct S5Par { float ar, ai, cr, ci; };
DI S5Par s5_par(const float* lre, const float* lim, const float* ldt, int dir, int g, int n) {
    const float dt = expf(ldt[dir * 32 + g]), lr = lre[(dir * 32 + g) * 64 + n], li = lim[(dir * 32 + g) * 64 + n];
    const float mag = expf(dt * lr); S5Par p; p.ar = mag * cosf(dt * li); p.ai = mag * sinf(dt * li);
    const float den = lr * lr + li * li, nr = p.ar - 1.0f; p.cr = (nr * lr + p.ai * li) / den; p.ci = (p.ai * lr - nr * li) / den; return p;
}
DI void s5_load_u(LAS float* us, const float* U, int b, int g, int c, int lane) {
    const u32x4* up = (const u32x4*)((const bf16_t*)U + (size_t)(b * SEQ + c * 64 + lane) * DSSM + g * 16);
#pragma unroll
    for (int j = 0; j < 2; ++j) { const u32x4 w = up[j];
        *(LAS f32x4*)(us + lane * 16 + 8 * j) = (f32x4){bflo(w.x), bfhi(w.x), bflo(w.y), bfhi(w.y)}; *(LAS f32x4*)(us + lane * 16 + 8 * j + 4) = (f32x4){bflo(w.z), bfhi(w.z), bflo(w.w), bfhi(w.w)}; }
    LDS_WAIT(); __builtin_amdgcn_wave_barrier();
}
DI void s5_bu(const LAS float* us, int t, const float (&Bre)[16], const float (&Bim)[16], float& bur, float& bui) {
    float r0 = 0.f, r1 = 0.f, i0 = 0.f, i1 = 0.f;
#pragma unroll
    for (int j = 0; j < 4; ++j) { const f32x4 u = *(const LAS f32x4*)(us + t * 16 + 4 * j);
        r0 += u[0] * Bre[4 * j + 0]; r1 += u[1] * Bre[4 * j + 1]; r0 += u[2] * Bre[4 * j + 2]; r1 += u[3] * Bre[4 * j + 3];
        i0 += u[0] * Bim[4 * j + 0]; i1 += u[1] * Bim[4 * j + 1]; i0 += u[2] * Bim[4 * j + 2]; i1 += u[3] * Bim[4 * j + 3]; }
    bur = r0 + r1; bui = i0 + i1;
}
struct URow { f32x4 v[4]; };
DI URow s5_ldu(const LAS float* us, int t) { URow u;
#pragma unroll
    for (int j = 0; j < 4; ++j) u.v[j] = *(const LAS f32x4*)(us + t * 16 + 4 * j);
    return u; }
DI void s5_bu_r(const URow& u, const float (&Bre)[16], const float (&Bim)[16], float& bur, float& bui) {
    float r0 = 0.f, r1 = 0.f, i0 = 0.f, i1 = 0.f;
#pragma unroll
    for (int j = 0; j < 4; ++j) {
        r0 += u.v[j][0] * Bre[4 * j + 0]; r1 += u.v[j][1] * Bre[4 * j + 1]; r0 += u.v[j][2] * Bre[4 * j + 2]; r1 += u.v[j][3] * Bre[4 * j + 3];
        i0 += u.v[j][0] * Bim[4 * j + 0]; i1 += u.v[j][1] * Bim[4 * j + 1]; i0 += u.v[j][2] * Bim[4 * j + 2]; i1 += u.v[j][3] * Bim[4 * j + 3]; }
    bur = r0 + r1; bui = i0 + i1;
}
DI void s5_pass1(LAS unsigned char* lds, const float* U, float* SE, const float* lre, const float* lim, const float* ldt, const float* bre, const float* bim, int gw, int NGW) {
    int tid_ = threadIdx.x; asm volatile("" : "+v"(tid_));
    const int lane = tid_ & 63, wave = __builtin_amdgcn_readfirstlane(tid_ >> 6);
    LAS float* us = (LAS float*)(lds + wave * S5_WAVE_LDS);
    for (int item = gw; item < 4096; item += NGW) {
        const int c = item & 63, bg = item >> 6, g = bg & 31, b = bg >> 5;
        const S5Par pf = s5_par(lre, lim, ldt, 0, g, lane), pb = s5_par(lre, lim, ldt, 1, g, lane);
        float Bre[16], Bim[16];
#pragma unroll
        for (int j = 0; j < 4; ++j) { const f32x4 a = *(const f32x4*)(bre + (size_t)(g * 64 + lane) * 16 + 4 * j), bb = *(const f32x4*)(bim + (size_t)(g * 64 + lane) * 16 + 4 * j);
#pragma unroll
            for (int e = 0; e < 4; ++e) { Bre[4 * j + e] = a[e]; Bim[4 * j + e] = bb[e]; } }
        s5_load_u(us, U, b, g, c, lane);
        float efr = 0.f, efi = 0.f, ebr = 0.f, ebi = 0.f, pwr = 1.f, pwi = 0.f;
#pragma unroll 4
        for (int t = 0; t < 64; ++t) {
            float bur, bui; s5_bu(us, t, Bre, Bim, bur, bui);
            const float fr_ = pf.cr * bur - pf.ci * bui, fi_ = pf.cr * bui + pf.ci * bur;
            const float nfr = pf.ar * efr - pf.ai * efi + fr_, nfi = pf.ar * efi + pf.ai * efr + fi_; efr = nfr; efi = nfi;
            const float br_ = pb.cr * bur - pb.ci * bui, bi_ = pb.cr * bui + pb.ci * bur;
            ebr += pwr * br_ - pwi * bi_; ebi += pwr * bi_ + pwi * br_;
            const float npr = pwr * pb.ar - pwi * pb.ai, npi = pwr * pb.ai + pwi * pb.ar; pwr = npr; pwi = npi;
        }
        float* se = SE + (size_t)item * 256 + lane; se[0] = efr; se[64] = efi; se[128] = ebr; se[192] = ebi;
        __builtin_amdgcn_wave_barrier();
    }
}
DI void s5_pass2(LAS unsigned char* lds, const float* U, const float* SE, bf16_t* YG, const float* lre, const float* lim, const float* ldt, const float* bre, const float* bim,
                 const float* cre, const float* cim, const float* dsk, int gw, int NGW) {
    int tid_ = threadIdx.x; asm volatile("" : "+v"(tid_));
    const int lane = tid_ & 63, wave = __builtin_amdgcn_readfirstlane(tid_ >> 6), l15 = lane & 15, l4 = lane >> 4;
    LAS float* us = (LAS float*)(lds + wave * S5_WAVE_LDS); LAS float* Ss = us + 1024;
    for (int item = gw; item < 4096; item += NGW) {
        const int c = item & 63, bg = item >> 6, g = bg & 31, b = bg >> 5;
        const S5Par pf = s5_par(lre, lim, ldt, 0, g, lane), pb = s5_par(lre, lim, ldt, 1, g, lane);
        float Bre[16], Bim[16], Cm[32];
#pragma unroll
        for (int j = 0; j < 4; ++j) { const f32x4 a = *(const f32x4*)(bre + (size_t)(g * 64 + lane) * 16 + 4 * j), bb = *(const f32x4*)(bim + (size_t)(g * 64 + lane) * 16 + 4 * j);
#pragma unroll
            for (int e = 0; e < 4; ++e) { Bre[4 * j + e] = a[e]; Bim[4 * j + e] = bb[e]; } }
#pragma unroll
        for (int m = 0; m < 16; ++m) { Cm[m] = cre[(size_t)(g * 16 + l15) * 64 + 4 * m + l4]; Cm[16 + m] = -cim[(size_t)(g * 16 + l15) * 64 + 4 * m + l4]; }
        s5_load_u(us, U, b, g, c, lane);
        float afr = pf.ar, afi = pf.ai, abr = pb.ar, abi = pb.ai;
#pragma unroll
        for (int i = 0; i < 6; ++i) { const float x = afr * afr - afi * afi, y = 2.f * afr * afi; afr = x; afi = y; const float z = abr * abr - abi * abi, w = 2.f * abr * abi; abr = z; abi = w; }
        float sfr = 0.f, sfi = 0.f, sbr = 0.f, sbi = 0.f;
        const float* seb = SE + (size_t)(bg * 64) * 256 + lane;
#pragma unroll 1
        for (int c8 = 0; c8 < 64; c8 += 8) {
            float er[8], ei[8], br[8], bi[8];
#pragma unroll
            for (int j = 0; j < 8; ++j) { er[j] = seb[(size_t)(c8 + j) * 256]; ei[j] = seb[(size_t)(c8 + j) * 256 + 64]; br[j] = seb[(size_t)(63 - c8 - j) * 256 + 128]; bi[j] = seb[(size_t)(63 - c8 - j) * 256 + 192]; }
#pragma unroll
            for (int j = 0; j < 8; ++j) {
                if (c8 + j < c) { const float x = afr * sfr - afi * sfi + er[j], y = afr * sfi + afi * sfr + ei[j]; sfr = x; sfi = y; }
                if (63 - c8 - j > c) { const float x = abr * sbr - abi * sbi + br[j], y = abr * sbi + abi * sbr + bi[j]; sbr = x; sbi = y; }
            }
        }
        f32x4 Y[4];
#pragma unroll
        for (int s = 0; s < 4; ++s) Y[s] = (f32x4){0.f, 0.f, 0.f, 0.f};
#pragma unroll
        for (int sub = 0; sub < 4; ++sub) {
            URow ucur = s5_ldu(us, 16 * sub);
#pragma unroll 4
            for (int tt = 0; tt < 16; ++tt) {
                const URow unxt = s5_ldu(us, (16 * sub + tt + 1) & 63);
                float bur, bui; s5_bu_r(ucur, Bre, Bim, bur, bui); ucur = unxt;
                const float fr_ = pf.cr * bur - pf.ci * bui, fi_ = pf.cr * bui + pf.ci * bur;
                const float x = pf.ar * sfr - pf.ai * sfi + fr_, y = pf.ar * sfi + pf.ai * sfr + fi_; sfr = x; sfi = y;
                Ss[tt * S5_SP + lane] = sfr; Ss[tt * S5_SP + 64 + lane] = sfi;
            }
            LDS_WAIT(); __builtin_amdgcn_wave_barrier();
#pragma unroll
            for (int m = 0; m < 32; ++m) { const float bv = Ss[l15 * S5_SP + 4 * m + l4]; Y[sub] = __builtin_amdgcn_mfma_f32_16x16x4f32(Cm[m], bv, Y[sub], 0, 0, 0); }
            LDS_WAIT(); __builtin_amdgcn_wave_barrier();
        }
#pragma unroll
        for (int sub = 3; sub >= 0; --sub) {
            URow ucur = s5_ldu(us, 16 * sub + 15);
#pragma unroll 4
            for (int tt = 15; tt >= 0; --tt) {
                const URow unxt = s5_ldu(us, (16 * sub + tt - 1) & 63);
                float bur, bui; s5_bu_r(ucur, Bre, Bim, bur, bui); ucur = unxt;
                const float br_ = pb.cr * bur - pb.ci * bui, bi_ = pb.cr * bui + pb.ci * bur;
                const float x = pb.ar * sbr - pb.ai * sbi + br_, y = pb.ar * sbi + pb.ai * sbr + bi_; sbr = x; sbi = y;
                Ss[tt * S5_SP + lane] = sbr; Ss[tt * S5_SP + 64 + lane] = sbi;
            }
            LDS_WAIT(); __builtin_amdgcn_wave_barrier();
#pragma unroll
            for (int m = 0; m < 32; ++m) { const float bv = Ss[l15 * S5_SP + 4 * m + l4]; Y[sub] = __builtin_amdgcn_mfma_f32_16x16x4f32(Cm[m], bv, Y[sub], 0, 0, 0); }
            LDS_WAIT(); __builtin_amdgcn_wave_barrier();
        }
        const f32x4 dv = *(const f32x4*)(dsk + g * 16 + 4 * l4);
#pragma unroll
        for (int sub = 0; sub < 4; ++sub) { const int t = 16 * sub + l15; const f32x4 uv = *(const LAS f32x4*)(us + t * 16 + 4 * l4);
            float y[4];
#pragma unroll
            for (int v = 0; v < 4; ++v) y[v] = gelu_tanh(Y[sub][v] + dv[v] * uv[v]);
            u32x2 w; w.x = pk2(y[0], y[1]); w.y = pk2(y[2], y[3]);
            *(u32x2*)(YG + (size_t)(b * SEQ + c * 64 + t) * DSSM + g * 16 + 4 * l4) = w; }
        LDS_WAIT(); __builtin_amdgcn_wave_barrier();
    }
}

DI void conv_phase(const bf16_t* BG, const bf16_t* CG, const bf16_t* XV, const float* cw, bf16_t* YC, int gt, int NT) {
    for (int idx = gt; idx < M * 64; idx += NT) {
        const int row = idx >> 6, ch = (idx & 63) * 8, t = row & (SEQ - 1);
        const size_t o = (size_t)row * DCONV + ch;
        const u32x4 zero = {0u, 0u, 0u, 0u};
        const u32x4 c1 = *(const u32x4*)(CG + o), x1 = *(const u32x4*)(XV + o), bgv = *(const u32x4*)(BG + o);
        const u32x4 c0 = t > 0 ? *(const u32x4*)(CG + o - DCONV) : zero, x0 = t > 0 ? *(const u32x4*)(XV + o - DCONV) : zero;
        const u32x4 c2 = t < SEQ - 1 ? *(const u32x4*)(CG + o + DCONV) : zero, x2 = t < SEQ - 1 ? *(const u32x4*)(XV + o + DCONV) : zero;
        float y[8];
#pragma unroll
        for (int j = 0; j < 4; ++j) {
            const float w0a = cw[ch + 2 * j], w0b = cw[ch + 2 * j + 1], w1a = cw[DCONV + ch + 2 * j], w1b = cw[DCONV + ch + 2 * j + 1], w2a = cw[2 * DCONV + ch + 2 * j], w2b = cw[2 * DCONV + ch + 2 * j + 1];
            y[2 * j] = bflo(bgv[j]) * (w0a * bflo(c0[j]) * bflo(x0[j]) + w1a * bflo(c1[j]) * bflo(x1[j]) + w2a * bflo(c2[j]) * bflo(x2[j]));
            y[2 * j + 1] = bfhi(bgv[j]) * (w0b * bfhi(c0[j]) * bfhi(x0[j]) + w1b * bfhi(c1[j]) * bfhi(x1[j]) + w2b * bfhi(c2[j]) * bfhi(x2[j]));
        }
        u32x4 w; w.x = pk2(y[0], y[1]); w.y = pk2(y[2], y[3]); w.z = pk2(y[4], y[5]); w.w = pk2(y[6], y[7]);
        *(u32x4*)(YC + o) = w;
    }
}

#define XB_TMO      128
#define XB_XCNT(j)  (256  + 64 * (j))
#define XB_XSUB(j)  (1280 + 64 * (j))
#define XB_XGEN(j)  (2304 + 64 * (j))
#define XB_TOP      3328
#define XB_TOPGEN   3392
#define XCD_BAR_WORDS 3456
#define XB_SPIN_CAP (1u << 18)
DI unsigned xb_ld(unsigned* p)              { return __hip_atomic_load(p, __ATOMIC_RELAXED, __HIP_MEMORY_SCOPE_AGENT); }
DI unsigned xb_add(unsigned* p, unsigned v) { return __hip_atomic_fetch_add(p, v, __ATOMIC_RELAXED, __HIP_MEMORY_SCOPE_AGENT); }
DI unsigned xb_xcc_id() { return (unsigned)__builtin_amdgcn_s_getreg((3 << 11) | 20) & 0xFu; }
#define XB_SPIN(cond, bar) do { unsigned _sp = 0; while (cond) { __builtin_amdgcn_s_sleep(1); \
    if ((++_sp & 255u) == 0u) { if (xb_ld(&(bar)[XB_TMO])) break; if (_sp > XB_SPIN_CAP) { atomicAdd(&(bar)[XB_TMO], 1u); break; } } } } while (0)
struct XcdBarrier { unsigned* bar; unsigned x; volatile LAS unsigned* st; };
DI XcdBarrier xcd_barrier_post(unsigned* bar, volatile LAS unsigned* st) {
    XcdBarrier b; b.bar = bar; b.x = xb_xcc_id(); b.st = st;
    if (threadIdx.x == 0) (void)xb_add(&bar[XB_XCNT(b.x)], 1u);
    return b;
}
DI void xcd_barrier_complete(unsigned* bar, unsigned x, unsigned& nloc, unsigned& nx) {
    const unsigned G = gridDim.x * gridDim.y * gridDim.z;
    unsigned sum, cnt, mine, sp = 0u;
    for (;;) {
        sum = 0u; cnt = 0u; mine = 0u;
#pragma unroll
        for (unsigned j = 0; j < 16; ++j) { const unsigned c = xb_ld(&bar[XB_XCNT(j)]); sum += c; cnt += (c > 0u) ? 1u : 0u; mine = (j == x) ? c : mine; }
        if (sum == G) break;
        __builtin_amdgcn_s_sleep(1);
        if ((++sp & 255u) == 0u) { if (xb_ld(&bar[XB_TMO])) break; if (sp > XB_SPIN_CAP) { atomicAdd(&bar[XB_TMO], 1u); break; } }
    }
    nloc = mine > 0u ? mine : 1u; nx = cnt > 0u ? cnt : 1u;
}
DI void xcd_barrier(const XcdBarrier& b) {
    asm volatile("s_waitcnt vmcnt(0)" ::: "memory");
    __syncthreads();
    if (threadIdx.x == 0) {
        unsigned* bar = b.bar;
        __builtin_amdgcn_s_waitcnt(0);
        unsigned nloc = b.st[0], nx = b.st[1];
        if (nloc == 0u) { xcd_barrier_complete(bar, b.x, nloc, nx); b.st[0] = nloc; b.st[1] = nx; }
        const unsigned old = xb_add(&bar[XB_XSUB(b.x)], 1u);
        const unsigned gen = old / nloc;
        if (old + 1u == (gen + 1u) * nloc) {
            __builtin_amdgcn_fence(__ATOMIC_RELEASE, "agent");
            asm volatile("s_waitcnt vmcnt(0)" ::: "memory");
            const unsigned og = xb_add(&bar[XB_TOP], 1u);
            const unsigned tg = og / nx;
            if (og + 1u == (tg + 1u) * nx) xb_add(&bar[XB_TOPGEN], 1u);
            else XB_SPIN(xb_ld(&bar[XB_TOPGEN]) == tg, bar);
            __builtin_amdgcn_fence(__ATOMIC_ACQUIRE, "agent");
            xb_add(&bar[XB_XGEN(b.x)], 1u);
            asm volatile("s_waitcnt vmcnt(0)" ::: "memory");
        } else {
            XB_SPIN(xb_ld(&bar[XB_XGEN(b.x)]) == gen, bar);
            __builtin_amdgcn_fence(__ATOMIC_ACQUIRE, "agent");
            asm volatile("s_waitcnt vmcnt(0)" ::: "memory");
        }
    }
    __syncthreads();
}

#ifndef REP_PREP
#define REP_PREP 1
#endif
#ifndef REP_NORM
#define REP_NORM 1
#endif
#ifndef REP_ATT
#define REP_ATT 1
#endif
#ifndef REP_S5
#define REP_S5 1
#endif
#ifndef REP_SYNC
#define REP_SYNC 1
#endif
#define GSYNC() do { for (int rs_ = 0; rs_ < REP_SYNC; ++rs_) xcd_barrier(xbar); } while (0)
struct Params { const float* in[23]; float* out; unsigned char* ws; };
template <int OFF> DI unsigned long long karg_u64() { unsigned long long v; auto ka = __builtin_amdgcn_kernarg_segment_ptr();
    asm volatile("s_load_dwordx2 %0, %1, %2\n\ts_waitcnt lgkmcnt(0)" : "=s"(v) : "s"(ka), "n"(OFF) : "memory"); return v; }
#define ARG_IN(i) ((const float*)(const __attribute__((address_space(1))) float*)karg_u64<8 * (i)>())
#define ARG_OUT() ((float*)(__attribute__((address_space(1))) float*)karg_u64<8 * 23>())
#define ARG_WS() ((unsigned char*)(__attribute__((address_space(1))) unsigned char*)karg_u64<8 * 24>())

__global__ void __launch_bounds__(512, 2) fwd_megakernel(Params p) {
    extern __shared__ __attribute__((aligned(16))) unsigned char lds_raw[];
    LAS unsigned char* lds = (LAS unsigned char*)lds_raw;
    cg::grid_group grid = cg::this_grid();
    const int G = gridDim.x, bid = blockIdx.x;
    if (threadIdx.x < 16) ((LAS unsigned*)(lds + LDS_MISC))[threadIdx.x] = 0u;
    if (bid == 0) { unsigned* bw = (unsigned*)(ARG_WS() + WS_BAR); for (int i = threadIdx.x; i < XCD_BAR_WORDS; i += 512) bw[i] = 0u; }
    __syncthreads();
#define IDS() int tidk = threadIdx.x; asm volatile("" : "+v"(tidk)); const int lane = tidk & 63, wave = __builtin_amdgcn_readfirstlane(tidk >> 6); \
    const int gw = bid * 8 + wave, NGW = G * 8, gt = bid * 512 + tidk, NT = G * 512; (void)lane; (void)gw; (void)NGW; (void)gt; (void)NT

    for (int rep_ = 0; rep_ < REP_PREP; ++rep_) {
        IDS(); unsigned char* ws = ARG_WS();
        LAS float* scr = (LAS float*)(lds + wave * 16384);
        { const float* w13 = ARG_IN(2); for (int i = 0; i < 4; ++i) conv_matrix(w13 + (size_t)i * DM * 2 * DFF, 2 * DFF, DM, 2 * DFF, (bf16_t*)(ws + WS_W13T + i * SZ_W13T), 1, gw, NGW, scr, lane); }
        { const float* w2 = ARG_IN(3); for (int i = 0; i < 4; ++i) conv_matrix(w2 + (size_t)i * DFF * DM, DM, DFF, DM, (bf16_t*)(ws + WS_W2T + i * SZ_W2T), 0, gw, NGW, scr, lane); }
        for (int l = 0; l < 2; ++l) {
            bf16_t* wc = (bf16_t*)(ws + WS_WCOMB + l * SZ_WCOMB);
            conv_matrix(ARG_IN(4) + (size_t)l * DM * DIN, DIN, DM, DIN, wc, 2, gw, NGW, scr, lane);
            conv_matrix(ARG_IN(19) + (size_t)l * DM * NGATE, NGATE, DM, NGATE, wc + (size_t)DIN * DM, 0, gw, NGW, scr, lane);
            conv_matrix(ARG_IN(13) + (size_t)l * DSSM * DSSM, DSSM, DSSM, DSSM, (bf16_t*)(ws + WS_WGLU + l * SZ_WGLU), 0, gw, NGW, scr, lane);
            bf16_t* wb = (bf16_t*)(ws + WS_WBR + l * SZ_WBR); const float* wbs = ARG_IN(18) + (size_t)l * DM * DM;
            conv_matrix(wbs, DM, DSSM, DM, wb, 0, gw, NGW, scr, lane);
            conv_matrix(wbs + (size_t)DSSM * DM, DM, DATT, DM, wb + (size_t)DM * DSSM, 0, gw, NGW, scr, lane);
            conv_matrix(wbs + (size_t)(DSSM + DATT) * DM, DM, DCONV, DM, wb + (size_t)DM * (DSSM + DATT), 0, gw, NGW, scr, lane);
            conv_matrix(ARG_IN(21) + (size_t)l * DM * DM, DM, DM, DM, (bf16_t*)(ws + WS_WOUT + l * SZ_WOUT), 0, gw, NGW, scr, lane);
        }
        float* COS = (float*)(ws + WS_ROPE); float* SIN = COS + SEQ * 32;
        for (int idx = gt; idx < SEQ * 32; idx += NT) { const int pos = idx >> 5, d = idx & 31; const float inv = powf(10000.0f, -(float)(2 * d) / 64.0f); const float ang = (float)pos * inv; COS[idx] = cosf(ang); SIN[idx] = sinf(ang); }
    }
    grid.sync();
    XcdBarrier xbar = xcd_barrier_post((unsigned*)(ARG_WS() + WS_BAR), (volatile LAS unsigned*)(lds + LDS_MISC));

    for (int l = 0; l < DEPTH; ++l) {
        { IDS(); unsigned char* ws = ARG_WS();
          if (l == 0) norm_rows<false>(ARG_IN(0), ARG_IN(1) + (size_t)(l * 3 + 0) * DM, ws + WS_H, gw, NGW, lane);
          else norm_rows_b<false>((const bf16_t*)(ws + WS_X), ARG_IN(1) + (size_t)(l * 3 + 0) * DM, ws + WS_H, gw, NGW, lane); }
        GSYNC();
        { unsigned char* ws = ARG_WS(); pg8::Gemm g{(const bf16_t*)(ws + WS_H), (const bf16_t*)(ws + WS_W13T + (size_t)(l * 2 + 0) * SZ_W13T), M, 2 * DFF, DM}; pg8::StaticOrder S; S.init(M, 2 * DFF, G, bid);
          pg8::EpiSwiglu E{(bf16_t*)(ws + WS_ACT)}; pg8::gemm_phase(lds, g, S, E); }
        GSYNC();
        { unsigned char* ws = ARG_WS();
          pg8::Gemm g{(const bf16_t*)(ws + WS_ACT), (const bf16_t*)(ws + WS_W2T + (size_t)(l * 2 + 0) * SZ_W2T), M, DM, DFF}; pg8::StaticOrder S; S.init(M, DM, G, bid);
          if (l == 0) { pg8::EpiResid<true> E{(const void*)ARG_IN(0), (bf16_t*)(ws + WS_X), 0.5f}; pg8::gemm_phase(lds, g, S, E); }
          else { pg8::EpiResid<false> E{(const void*)(ws + WS_X), (bf16_t*)(ws + WS_X), 0.5f}; pg8::gemm_phase(lds, g, S, E); } }
        GSYNC();
        for (int rep_ = 0; rep_ < REP_NORM; ++rep_) { IDS(); unsigned char* ws = ARG_WS(); norm_rows_b<false>((const bf16_t*)(ws + WS_X), ARG_IN(1) + (size_t)(l * 3 + 1) * DM, ws + WS_H, gw, NGW, lane); }
        GSYNC();
        { unsigned char* ws = ARG_WS(); pg8::Gemm g{(const bf16_t*)(ws + WS_H), (const bf16_t*)(ws + WS_WCOMB + (size_t)l * SZ_WCOMB), M, NCOMB, DM}; pg8::StaticOrder S; S.init(M, NCOMB, G, bid);
          pg8::EpiInGate E{ws, ARG_IN(20) + (size_t)l * NGATE};
          pg8::gemm_phase(lds, g, S, E); }
        GSYNC();
        for (int rep_ = 0; rep_ < REP_S5; ++rep_) { IDS(); unsigned char* ws = ARG_WS();
          s5_pass1(lds, (const float*)(ws + WS_U), (float*)(ws + WS_SE), ARG_IN(5) + (size_t)l * 4096, ARG_IN(6) + (size_t)l * 4096, ARG_IN(7) + (size_t)l * 64,
                   ARG_IN(8) + (size_t)l * 32768, ARG_IN(9) + (size_t)l * 32768, gw, NGW);
          conv_phase((const bf16_t*)(ws + WS_BG), (const bf16_t*)(ws + WS_CG), (const bf16_t*)(ws + WS_XV), ARG_IN(17) + (size_t)l * 3 * DCONV, (bf16_t*)(ws + WS_YC), gt, NT); }
        GSYNC();
        for (int rep_ = 0; rep_ < REP_ATT; ++rep_) { unsigned char* ws = ARG_WS(); const float lambda_init = 0.8f - 0.6f * expf(-0.3f * (float)l);
          const int vcu = (G % 8 == 0) ? (bid % 8) * (G / 8) + bid / 8 : bid;
          attn_phase(lds, (const bf16_t*)(ws + WS_Q), (const bf16_t*)(ws + WS_K), (const bf16_t*)(ws + WS_V), (bf16_t*)(ws + WS_YB), ARG_IN(15) + (size_t)l * 256, ARG_IN(16) + (size_t)l * 128, lambda_init, vcu, G); }
        for (int rep_ = 0; rep_ < REP_S5; ++rep_) { IDS(); unsigned char* ws = ARG_WS();
          s5_pass2(lds, (const float*)(ws + WS_U), (const float*)(ws + WS_SE), (bf16_t*)(ws + WS_YG), ARG_IN(5) + (size_t)l * 4096, ARG_IN(6) + (size_t)l * 4096, ARG_IN(7) + (size_t)l * 64,
                   ARG_IN(8) + (size_t)l * 32768, ARG_IN(9) + (size_t)l * 32768, ARG_IN(10) + (size_t)l * 32768, ARG_IN(11) + (size_t)l * 32768, ARG_IN(12) + (size_t)l * DSSM, gw, NGW); }
        GSYNC();
        { unsigned char* ws = ARG_WS(); pg8::Gemm g{(const bf16_t*)(ws + WS_YG), (const bf16_t*)(ws + WS_WGLU + (size_t)l * SZ_WGLU), M, DSSM, DSSM}; pg8::StaticOrder S; S.init(M, DSSM, G, bid);
          pg8::EpiGLU E{(const bf16_t*)(ws + WS_YG), (bf16_t*)(ws + WS_YA), ARG_IN(14) + (size_t)l * DSSM}; pg8::gemm_phase(lds, g, S, E); }
        GSYNC();
        { unsigned char* ws = ARG_WS(); const bf16_t* wb = (const bf16_t*)(ws + WS_WBR + (size_t)l * SZ_WBR); pg8::StaticOrder S; S.init(M, DM, G, bid);
          pg8::Gemm g{(const bf16_t*)(ws + WS_YA), wb, M, DM, DSSM}; pg8::EpiBranch<0> E{(const bf16_t*)(ws + WS_GATE), (float*)(ws + WS_MF), (bf16_t*)(ws + WS_MB)}; pg8::gemm_phase(lds, g, S, E); }
        { unsigned char* ws = ARG_WS(); const bf16_t* wb = (const bf16_t*)(ws + WS_WBR + (size_t)l * SZ_WBR); pg8::StaticOrder S; S.init(M, DM, G, bid);
          pg8::Gemm g{(const bf16_t*)(ws + WS_YB), wb + (size_t)DM * DSSM, M, DM, DATT}; pg8::EpiBranch<1> E{(const bf16_t*)(ws + WS_GATE), (float*)(ws + WS_MF), (bf16_t*)(ws + WS_MB)}; pg8::gemm_phase(lds, g, S, E); }
        { unsigned char* ws = ARG_WS(); const bf16_t* wb = (const bf16_t*)(ws + WS_WBR + (size_t)l * SZ_WBR); pg8::StaticOrder S; S.init(M, DM, G, bid);
          pg8::Gemm g{(const bf16_t*)(ws + WS_YC), wb + (size_t)DM * (DSSM + DATT), M, DM, DCONV}; pg8::EpiBranch<2> E{(const bf16_t*)(ws + WS_GATE), (float*)(ws + WS_MF), (bf16_t*)(ws + WS_MB)}; pg8::gemm_phase(lds, g, S, E); }
        GSYNC();
        { unsigned char* ws = ARG_WS(); pg8::Gemm g{(const bf16_t*)(ws + WS_MB), (const bf16_t*)(ws + WS_WOUT + (size_t)l * SZ_WOUT), M, DM, DM}; pg8::StaticOrder S; S.init(M, DM, G, bid);
          pg8::EpiResid<false> E{(const void*)(ws + WS_X), (bf16_t*)(ws + WS_X), 1.0f}; pg8::gemm_phase(lds, g, S, E); }
        GSYNC();
        for (int rep_ = 0; rep_ < REP_NORM; ++rep_) { IDS(); unsigned char* ws = ARG_WS(); norm_rows_b<false>((const bf16_t*)(ws + WS_X), ARG_IN(1) + (size_t)(l * 3 + 2) * DM, ws + WS_H, gw, NGW, lane); }
        GSYNC();
        { unsigned char* ws = ARG_WS(); pg8::Gemm g{(const bf16_t*)(ws + WS_H), (const bf16_t*)(ws + WS_W13T + (size_t)(l * 2 + 1) * SZ_W13T), M, 2 * DFF, DM}; pg8::StaticOrder S; S.init(M, 2 * DFF, G, bid);
          pg8::EpiSwiglu E{(bf16_t*)(ws + WS_ACT)}; pg8::gemm_phase(lds, g, S, E); }
        GSYNC();
        { unsigned char* ws = ARG_WS(); pg8::Gemm g{(const bf16_t*)(ws + WS_ACT), (const bf16_t*)(ws + WS_W2T + (size_t)(l * 2 + 1) * SZ_W2T), M, DM, DFF}; pg8::StaticOrder S; S.init(M, DM, G, bid);
          pg8::EpiResid<false> E{(const void*)(ws + WS_X), (bf16_t*)(ws + WS_X), 0.5f}; pg8::gemm_phase(lds, g, S, E); }
        GSYNC();
    }
    for (int rep_ = 0; rep_ < REP_NORM; ++rep_) { IDS(); unsigned char* ws = ARG_WS(); norm_rows_b<true>((const bf16_t*)(ws + WS_X), ARG_IN(22), ARG_OUT(), gw, NGW, lane); }
}

extern "C" void kernel_launch(void* const* d_in, const int* in_sizes, int n_in, void* d_out, int out_size, void* d_ws, size_t ws_size, hipStream_t stream) {
    static int grid_blocks = 0;
    if (!grid_blocks) {
        if (n_in != 23 || out_size != M * DM || ws_size < WS_END) { fprintf(stderr, "kernel_launch: unexpected problem (n_in %d out %d ws %zu need %zu)\n", n_in, out_size, ws_size, (size_t)WS_END); grid_blocks = -1; return; }
        int dev = 0, cus = 0, per_cu = 0;
        (void)hipGetDevice(&dev);
        (void)hipDeviceGetAttribute(&cus, hipDeviceAttributeMultiprocessorCount, dev);
        (void)hipFuncSetAttribute((const void*)fwd_megakernel, hipFuncAttributeMaxDynamicSharedMemorySize, LDS_BYTES);
        (void)hipOccupancyMaxActiveBlocksPerMultiprocessor(&per_cu, (const void*)fwd_megakernel, 512, LDS_BYTES);
        if (per_cu < 1) per_cu = 1;
        grid_blocks = cus * per_cu;
    }
    if (grid_blocks < 0) return;
    Params p{};
    for (int i = 0; i < 23; ++i) p.in[i] = (const float*)d_in[i];
    p.out = (float*)d_out; p.ws = (unsigned char*)d_ws;
    void* args[] = {&p};
    hipError_t e = hipLaunchCooperativeKernel((void*)fwd_megakernel, dim3(grid_blocks), dim3(512), args, LDS_BYTES, stream);
    if (e != hipSuccess) fprintf(stderr, "cooperative launch failed: %s (grid %d)\n", hipGetErrorString(e), grid_blocks);
}
```

```cpp
#include <hip/hip_runtime.h>
#include <hip/hip_cooperative_groups.h>
#include <cstdio>
#include <cmath>
namespace cg = cooperative_groups;

#define LAS __attribute__((address_space(3)))
#define DI __device__ __forceinline__
typedef unsigned short bf16_t;
typedef short bf16x8 __attribute__((ext_vector_type(8)));
typedef short s16x4 __attribute__((ext_vector_type(4)));
typedef float f32x4 __attribute__((ext_vector_type(4)));
typedef float f32x16 __attribute__((ext_vector_type(16)));
typedef unsigned u32x4 __attribute__((ext_vector_type(4)));
typedef unsigned u32x2 __attribute__((ext_vector_type(2)));

constexpr int SEQ = 4096, M = 8192, DM = 2048, DFF = 5504, DSSM = 512, DATT = 1024, DCONV = 512, DIN = 5120, NGATE = 6144, NCOMB = DIN + NGATE, DEPTH = 2;
constexpr int LDS_BYTES = 147456, LDS_MISC = 147456 - 64;
constexpr float C2 = 0.125f * 1.4426950408889634f;

constexpr size_t al256(size_t x) { return (x + 255) & ~(size_t)255; }
constexpr size_t SZ_W13T = (size_t)2 * DFF * DM * 2, SZ_W2T = (size_t)DM * DFF * 2, SZ_WCOMB = (size_t)NCOMB * DM * 2, SZ_WGLU = (size_t)DSSM * DSSM * 2;
constexpr size_t SZ_WBR = (size_t)DM * DM * 2, SZ_WOUT = (size_t)DM * DM * 2;
constexpr size_t WS_W13T = 0;
constexpr size_t WS_W2T = WS_W13T + 4 * SZ_W13T;
constexpr size_t WS_WCOMB = WS_W2T + 4 * SZ_W2T;
constexpr size_t WS_WGLU = WS_WCOMB + 2 * SZ_WCOMB;
constexpr size_t WS_WBR = WS_WGLU + 2 * SZ_WGLU;
constexpr size_t WS_WOUT = WS_WBR + 2 * SZ_WBR;
constexpr size_t WS_ROPE = WS_WOUT + 2 * SZ_WOUT;
constexpr size_t WS_X = WS_ROPE + (size_t)2 * SEQ * 32 * 4;
constexpr size_t WS_H = WS_X + (size_t)M * DM * 4;
constexpr size_t WS_ACT = WS_H + (size_t)M * DM * 2;
constexpr size_t WS_U = WS_ACT + (size_t)M * DFF * 2;
constexpr size_t WS_Q = WS_U + (size_t)M * DSSM * 4;
constexpr size_t WS_K = WS_Q + (size_t)M * DATT * 2;
constexpr size_t WS_V = WS_K + (size_t)M * DATT * 2;
constexpr size_t WS_BG = WS_V + (size_t)M * DATT * 2;
constexpr size_t WS_CG = WS_BG + (size_t)M * DCONV * 2;
constexpr size_t WS_XV = WS_CG + (size_t)M * DCONV * 2;
constexpr size_t WS_GATE = WS_XV + (size_t)M * DCONV * 2;
constexpr size_t WS_YG = WS_GATE + (size_t)M * NGATE * 2;
constexpr size_t WS_YA = WS_YG + (size_t)M * DSSM * 2;
constexpr size_t WS_YB = WS_YA + (size_t)M * DSSM * 2;
constexpr size_t WS_YC = WS_YB + (size_t)M * DATT * 2;
constexpr size_t WS_MF = WS_YC + (size_t)M * DCONV * 2;
constexpr size_t WS_MB = WS_MF + (size_t)M * DM * 4;
constexpr size_t WS_SE = WS_MB + (size_t)M * DM * 2;
constexpr size_t WS_BAR = WS_SE + (size_t)4096 * 256 * 4;
constexpr size_t WS_END = WS_BAR + 16384;

typedef float f32x2_t __attribute__((ext_vector_type(2))); typedef __bf16 bf16x2_t __attribute__((ext_vector_type(2)));
DI unsigned pk2(float lo, float hi) { f32x2_t v = {lo, hi}; bf16x2_t b = __builtin_convertvector(v, bf16x2_t); return __builtin_bit_cast(unsigned, b); }
DI float bflo(unsigned w) { return __uint_as_float(w << 16); }
DI float bfhi(unsigned w) { return __uint_as_float(w & 0xffff0000u); }
DI float wave_sum(float v) {
#pragma unroll
    for (int o = 1; o < 64; o <<= 1) v += __shfl_xor(v, o);
    return v;
}
DI float sigmoidf_(float x) { return __builtin_amdgcn_rcpf(1.0f + __builtin_amdgcn_exp2f(-1.4426950408889634f * x)); }
DI float siluf_(float x) { return x * sigmoidf_(x); }
DI float gelu_tanh(float y) { const float z = 0.7978845608028654f * (y + 0.044715f * y * y * y); const float t = 1.0f - 2.0f / (1.0f + __expf(2.0f * z)); return 0.5f * y * (1.0f + t); }
#define LDS_WAIT() asm volatile("s_waitcnt lgkmcnt(0)" ::: "memory")

namespace pg8 {
constexpr int BM = 256, BK = 64, HALF = 128, HTB = HALF * BK * 2, STAGE_BYTES = 8 * HTB, NXCD = 8, WGM = 8;
DI int lds_byte(int r, int c) { const int st = (r >> 4) * 2 + (c >> 5), rr = r & 15, cc = c & 31, ob = rr * 64 + cc * 2; return st * 1024 + (ob ^ (((ob >> 9) & 1) << 5)); }
DI void stage_rc(int b, int& R, int& C) { const int st = b / 1024, sb = b % 1024, swz = sb ^ (((sb >> 9) & 1) << 5); R = (st >> 1) * 16 + swz / 64; C = (st & 1) * 32 + (swz % 64) / 2; }
DI int perm32(int rho) { const int n = rho >> 4, i = rho & 15; return 8 * (i >> 2) + 4 * n + (i & 3); }
struct Unit { int pm, pn, koff, nt, seg; };
struct Gemm { const bf16_t* A; const bf16_t* Bt; int M, N, K; };
struct StaticOrder {
    int nM, nN, nwg, G, c;
    DI void init(int M_, int N_, int G_, int c_) { nM = M_ / BM; nN = N_ / BM; nwg = nM * nN; G = G_; c = c_; }
    DI bool next(int i, Unit& u) const {
        const long L = (long)i * G + c; if (L >= nwg) return false;
        int wgid = (int)L; { const int q = nwg / NXCD, r = nwg % NXCD, xcd = wgid % NXCD, off = wgid / NXCD; wgid = (xcd < r ? xcd * (q + 1) : r * (q + 1) + (xcd - r) * q) + off; }
        const int nig = WGM * nN, gid = wgid / nig, fm = gid * WGM, gsz = (nM - fm) < WGM ? (nM - fm) : WGM;
        u.pm = fm + ((wgid % nig) % gsz); u.pn = (wgid % nig) / gsz; u.koff = 0; u.nt = 0; u.seg = 0; return true;
    }
};
struct BranchOrder { StaticOrder base;
    DI bool next(int i, Unit& u) const { if (!base.next(i / 3, u)) return false; const int sg = i % 3; u.seg = sg; u.koff = sg == 0 ? 0 : (sg == 1 ? DSSM : DSSM + DATT); u.nt = sg == 1 ? DATT / BK : DSSM / BK; return true; }
};
template <class Epi, class Sched = StaticOrder, bool ALIGN_EPI = true, bool SP2 = true>
DI void gemm_phase(LAS unsigned char* lds, const Gemm g, const Sched& S, const Epi& E) {
    int tid_ = threadIdx.x; asm volatile("" : "+v"(tid_));
    const int tid = tid_, wid = __builtin_amdgcn_readfirstlane(tid >> 6), lane = tid & 63, wr = wid >> 2, wc = wid & 3, fr = lane & 15, fq = lane >> 4;
    const int K = g.K, nt = K / BK;
    unsigned voffA[2], voffB[2];
#pragma unroll
    for (int i = 0; i < 2; ++i) { int R, C; stage_rc(tid * 16 + i * 8192, R, C); const int Rb = Epi::PERM ? ((R & ~31) + perm32(R & 31)) : R;
        voffA[i] = (unsigned)(R * K + C) * 2u; voffB[i] = (unsigned)(Rb * K + C) * 2u; }
    const size_t kstep = (size_t)(BK * 2);
    const size_t hstep = (size_t)HALF * K * 2;
    const size_t tstep = 2 * hstep;
    const unsigned ldsw = (unsigned)wid * 1024u;
    const int aoff = lds_byte(wr * 64 + fr, fq * 8), boff = lds_byte(wc * 32 + fr, fq * 8);
#define PG8_SA(b, h) (((b) * 2 + (h)) * HTB)
#define PG8_SB(b, h) ((4 + (b) * 2 + (h)) * HTB)
#define PG8_STAGE(bufoff, gbase, voff) do { _Pragma("unroll") for (int _i = 0; _i < 2; ++_i) \
        __builtin_amdgcn_global_load_lds((const unsigned*)((const char*)(gbase) + (voff)[_i]), (LAS unsigned*)(lds + (bufoff) + ldsw + _i * 8192), 16, 0, 0); } while (0)
#define PG8_LDA(dst, b, h) do { _Pragma("unroll") for (int m = 0; m < 4; ++m) _Pragma("unroll") for (int k = 0; k < 2; ++k) dst[m][k] = *(const LAS bf16x8*)(lds + PG8_SA(b, h) + aoff + m * 2048 + k * 1024); } while (0)
#define PG8_LDB(dst, b, h) do { _Pragma("unroll") for (int n = 0; n < 2; ++n) _Pragma("unroll") for (int k = 0; k < 2; ++k) dst[n][k] = *(const LAS bf16x8*)(lds + PG8_SB(b, h) + boff + n * 2048 + k * 1024); } while (0)
#define PG8_MMA(ai, bj, At, Bt) do { __builtin_amdgcn_s_setprio(1); _Pragma("unroll") for (int m = 0; m < 4; ++m) _Pragma("unroll") for (int n = 0; n < 2; ++n) _Pragma("unroll") for (int k = 0; k < 2; ++k) \
        acc[ai][bj][m][n] = __builtin_amdgcn_mfma_f32_16x16x32_bf16(Bt[n][k], At[m][k], acc[ai][bj][m][n], 0, 0, 0); __builtin_amdgcn_s_setprio(0); } while (0)
#define PG8_WAIT_V(n) asm volatile("s_waitcnt vmcnt(" #n ")" ::: "memory")
#define PG8_WAIT_L(n) asm volatile("s_waitcnt lgkmcnt(" #n ")" ::: "memory")
#define PG8_BAR __builtin_amdgcn_s_barrier()
#define PG8_SCHED __builtin_amdgcn_sched_barrier(0)
    Unit cur, nxt; int ui = 0;
    if (!S.next(0, cur)) return;
    f32x4 acc[2][2][4][2];
#pragma unroll
    for (int a = 0; a < 2; ++a)
#pragma unroll
        for (int b = 0; b < 2; ++b)
#pragma unroll
            for (int m = 0; m < 4; ++m)
#pragma unroll
                for (int n = 0; n < 2; ++n) acc[a][b][m][n] = (f32x4){0.f, 0.f, 0.f, 0.f};
    bf16x8 At[4][2], B0[2][2], B1[2][2];
    const char* cA = (const char*)g.A + (size_t)cur.pm * tstep + (size_t)cur.koff * 2; const char* cB = (const char*)g.Bt + (size_t)cur.pn * tstep + (size_t)cur.koff * 2;
    int ntc = cur.nt ? cur.nt : nt;
    if constexpr (SP2) {
        PG8_STAGE(PG8_SB(0, 0), cB, voffB); PG8_STAGE(PG8_SB(0, 1), cB + hstep, voffB); PG8_STAGE(PG8_SA(0, 0), cA, voffA); PG8_STAGE(PG8_SA(0, 1), cA + hstep, voffA);
        if (wr == 1) PG8_BAR;
        PG8_WAIT_V(2); PG8_BAR;
        PG8_STAGE(PG8_SB(1, 0), cB + kstep, voffB); PG8_STAGE(PG8_SA(1, 0), cA + kstep, voffA); PG8_STAGE(PG8_SB(1, 1), cB + hstep + kstep, voffB);
        PG8_WAIT_V(6); PG8_BAR;
    } else {
        PG8_STAGE(PG8_SB(0, 0), cB, voffB); PG8_STAGE(PG8_SA(0, 0), cA, voffA); PG8_STAGE(PG8_SB(0, 1), cB + hstep, voffB); PG8_STAGE(PG8_SA(0, 1), cA + hstep, voffA);
        if (wr == 1) PG8_BAR;
        PG8_WAIT_V(4); PG8_BAR;
        PG8_STAGE(PG8_SB(1, 0), cB + kstep, voffB); PG8_STAGE(PG8_SA(1, 0), cA + kstep, voffA); PG8_STAGE(PG8_SB(1, 1), cB + hstep + kstep, voffB);
        PG8_WAIT_V(6); PG8_BAR;
    }
    for (;;) {
        const bool has_next = S.next(ui + 1, nxt);
        const char* nA = has_next ? (const char*)g.A + (size_t)nxt.pm * tstep + (size_t)nxt.koff * 2 : cA; const char* nB = has_next ? (const char*)g.Bt + (size_t)nxt.pn * tstep + (size_t)nxt.koff * 2 : cB;
        for (int t = 0; t < ntc; t += 2) {
            const bool last = (t == ntc - 2);
            const char* a1 = cA + (size_t)(t + 1) * kstep;
            const char* a2 = last ? nA : cA + (size_t)(t + 2) * kstep; const char* b2 = last ? nB : cB + (size_t)(t + 2) * kstep;
            const char* a3 = a2 + kstep; const char* b3 = b2 + kstep;
            if constexpr (SP2) {
            PG8_LDB(B0, 0, 0); PG8_LDB(B1, 0, 1); PG8_SCHED; PG8_LDA(At, 0, 0); PG8_STAGE(PG8_SA(1, 1), a1 + hstep, voffA);
            PG8_WAIT_V(8); PG8_WAIT_L(0); PG8_BAR; PG8_MMA(0, 0, At, B0); PG8_MMA(0, 1, At, B1); PG8_BAR; PG8_SCHED;
            PG8_LDA(At, 0, 1); PG8_STAGE(PG8_SB(0, 0), b2, voffB); PG8_STAGE(PG8_SB(0, 1), b2 + hstep, voffB); PG8_STAGE(PG8_SA(0, 0), a2, voffA);
            PG8_WAIT_V(8); PG8_WAIT_L(0); PG8_BAR; PG8_MMA(1, 0, At, B0); PG8_MMA(1, 1, At, B1); PG8_BAR; PG8_SCHED;
            PG8_LDB(B0, 1, 0); PG8_LDB(B1, 1, 1); PG8_SCHED; PG8_LDA(At, 1, 0); PG8_STAGE(PG8_SA(0, 1), a2 + hstep, voffA);
            PG8_WAIT_V(8); PG8_WAIT_L(0); PG8_BAR; PG8_MMA(0, 0, At, B0); PG8_MMA(0, 1, At, B1); PG8_BAR; PG8_SCHED;
            PG8_LDA(At, 1, 1); PG8_STAGE(PG8_SB(1, 0), b3, voffB); PG8_STAGE(PG8_SB(1, 1), b3 + hstep, voffB); PG8_STAGE(PG8_SA(1, 0), a3, voffA);
            PG8_WAIT_V(8); PG8_WAIT_L(0); PG8_BAR; PG8_MMA(1, 0, At, B0); PG8_MMA(1, 1, At, B1); PG8_BAR; PG8_SCHED;
            } else {
            PG8_LDB(B0, 0, 0); PG8_SCHED; PG8_LDA(At, 0, 0); PG8_STAGE(PG8_SA(1, 1), a1 + hstep, voffA);
            PG8_WAIT_L(8); PG8_BAR; PG8_WAIT_L(0); PG8_MMA(0, 0, At, B0); PG8_BAR; PG8_SCHED;
            PG8_LDB(B1, 0, 1); PG8_STAGE(PG8_SB(0, 0), b2, voffB);
            PG8_BAR; PG8_WAIT_L(0); PG8_MMA(0, 1, At, B1); PG8_BAR;
            PG8_LDA(At, 0, 1); PG8_STAGE(PG8_SA(0, 0), a2, voffA);
            PG8_BAR; PG8_WAIT_L(0); PG8_MMA(1, 0, At, B0); PG8_BAR; PG8_SCHED;
            PG8_STAGE(PG8_SB(0, 1), b2 + hstep, voffB);
            PG8_WAIT_V(6); PG8_BAR; PG8_MMA(1, 1, At, B1); PG8_BAR;
            PG8_LDB(B0, 1, 0); PG8_SCHED; PG8_LDA(At, 1, 0); PG8_STAGE(PG8_SA(0, 1), a2 + hstep, voffA);
            PG8_WAIT_L(8); PG8_BAR; PG8_WAIT_L(0); PG8_MMA(0, 0, At, B0); PG8_BAR; PG8_SCHED;
            PG8_LDB(B1, 1, 1); PG8_STAGE(PG8_SB(1, 0), b3, voffB);
            PG8_BAR; PG8_WAIT_L(0); PG8_MMA(0, 1, At, B1); PG8_BAR;
            PG8_LDA(At, 1, 1); PG8_STAGE(PG8_SA(1, 0), a3, voffA);
            PG8_BAR; PG8_WAIT_L(0); PG8_MMA(1, 0, At, B0); PG8_BAR; PG8_SCHED;
            PG8_STAGE(PG8_SB(1, 1), b3 + hstep, voffB);
            PG8_WAIT_V(6); PG8_BAR; PG8_MMA(1, 1, At, B1); PG8_BAR;
            }
        }
        if constexpr (ALIGN_EPI) { if (wr == 0) PG8_BAR; }
        E(acc, cur, wr, wc, fr, fq);
        if (!has_next) break;
        if (!(Epi::HOOK && nxt.seg != 0)) {
#pragma unroll
        for (int a = 0; a < 2; ++a)
#pragma unroll
            for (int b = 0; b < 2; ++b)
#pragma unroll
                for (int m = 0; m < 4; ++m)
#pragma unroll
                    for (int n = 0; n < 2; ++n) acc[a][b][m][n] = (f32x4){0.f, 0.f, 0.f, 0.f};
        }
        cur = nxt; cA = nA; cB = nB; ++ui; ntc = cur.nt ? cur.nt : nt;
        if constexpr (ALIGN_EPI) { if (wr == 1) PG8_BAR; }
    }
    PG8_WAIT_V(0);
    if constexpr (!ALIGN_EPI) { if (wr == 0) PG8_BAR; }
    PG8_BAR;
#undef PG8_SA
#undef PG8_SB
#undef PG8_STAGE
#undef PG8_LDA
#undef PG8_LDB
#undef PG8_MMA
#undef PG8_WAIT_V
#undef PG8_WAIT_L
#undef PG8_BAR
#undef PG8_SCHED
}
typedef f32x4 Acc[2][2][4][2];

struct EpiSwiglu {
    static constexpr bool PERM = true, HOOK = false; bf16_t* O;
    DI void operator()(const Acc& acc, const Unit& u, int wr, int wc, int fr, int fq) const {
        const int row0 = u.pm * BM + wr * 64 + fr, col0 = u.pn * 128 + wc * 32 + 8 * fq;
#pragma unroll
        for (int ai = 0; ai < 2; ++ai)
#pragma unroll
            for (int m = 0; m < 4; ++m) {
                bf16_t* rowp = O + (size_t)(row0 + ai * HALF + m * 16) * DFF + col0;
                const f32x4 a0 = acc[ai][0][m][0], a1 = acc[ai][0][m][1], b0 = acc[ai][1][m][0], b1 = acc[ai][1][m][1];
                float v[8];
#pragma unroll
                for (int e = 0; e < 4; ++e) { v[e] = siluf_(a0[e]) * b0[e]; v[4 + e] = siluf_(a1[e]) * b1[e]; }
                u32x4 w; w.x = pk2(v[0], v[1]); w.y = pk2(v[2], v[3]); w.z = pk2(v[4], v[5]); w.w = pk2(v[6], v[7]);
                *(u32x4*)rowp = w;
            }
    }
};
template <bool SRC_F32> struct EpiResid {
    static constexpr bool PERM = true, HOOK = false; const void* src; bf16_t* dst; float scale;
    struct Grp { f32x4 f[4]; u32x4 h[2]; };
    DI void operator()(const Acc& acc, const Unit& u, int wr, int wc, int fr, int fq) const {
        const int row0 = u.pm * BM + wr * 64 + fr, col0 = u.pn * BM + wc * 32 + 8 * fq;
        Grp cur, nxt;
#define ER_LOAD(dstv, g) do { const size_t off_ = (size_t)(row0 + ((g) >> 2) * HALF + ((g) & 3) * 16) * DM + col0; \
        _Pragma("unroll") for (int bj_ = 0; bj_ < 2; ++bj_) { if (SRC_F32) { dstv.f[2 * bj_] = *(const f32x4*)((const float*)src + off_ + bj_ * HALF); dstv.f[2 * bj_ + 1] = *(const f32x4*)((const float*)src + off_ + bj_ * HALF + 4); } \
            else dstv.h[bj_] = *(const u32x4*)((const bf16_t*)src + off_ + bj_ * HALF); } } while (0)
        ER_LOAD(cur, 0);
#pragma unroll
        for (int g = 0; g < 8; ++g) {
            if (g < 7) ER_LOAD(nxt, g + 1);
            const size_t off = (size_t)(row0 + (g >> 2) * HALF + (g & 3) * 16) * DM + col0;
#pragma unroll
            for (int bj = 0; bj < 2; ++bj) { f32x4 s0, s1;
                if (SRC_F32) { s0 = cur.f[2 * bj]; s1 = cur.f[2 * bj + 1]; }
                else { const u32x4 hw = cur.h[bj]; s0 = (f32x4){bflo(hw.x), bfhi(hw.x), bflo(hw.y), bfhi(hw.y)}; s1 = (f32x4){bflo(hw.z), bfhi(hw.z), bflo(hw.w), bfhi(hw.w)}; }
                const f32x4 v0 = s0 + acc[g >> 2][bj][g & 3][0] * scale, v1 = s1 + acc[g >> 2][bj][g & 3][1] * scale;
                u32x4 w; w.x = pk2(v0[0], v0[1]); w.y = pk2(v0[2], v0[3]); w.z = pk2(v1[0], v1[1]); w.w = pk2(v1[2], v1[3]);
                *(u32x4*)(dst + off + bj * HALF) = w; }
            cur = nxt;
        }
#undef ER_LOAD
    }
};
struct EpiInGate {
    static constexpr bool PERM = true, HOOK = false;
    unsigned char* ws; const float* bgate;
    DI void operator()(const Acc& acc, const Unit& u, int wr, int wc, int fr, int fq) const {
        const int pn = u.pn, row0 = u.pm * BM + wr * 64 + fr, cl0 = wc * 32 + 8 * fq;
        float* U = (float*)(ws + WS_U); bf16_t* GATE = (bf16_t*)(ws + WS_GATE); const float* COS = (const float*)(ws + WS_ROPE); const float* SIN = COS + SEQ * 32;
        if (pn < 2) {
#pragma unroll
            for (int ai = 0; ai < 2; ++ai)
#pragma unroll
                for (int m = 0; m < 4; ++m) { bf16_t* rowp = (bf16_t*)U + (size_t)(row0 + ai * HALF + m * 16) * DSSM + pn * 256 + cl0;
#pragma unroll
                    for (int bj = 0; bj < 2; ++bj) { const f32x4 v0 = acc[ai][bj][m][0], v1 = acc[ai][bj][m][1];
                        u32x4 w; w.x = pk2(v0[0], v0[1]); w.y = pk2(v0[2], v0[3]); w.z = pk2(v1[0], v1[1]); w.w = pk2(v1[2], v1[3]); *(u32x4*)(rowp + bj * HALF) = w; } }
        } else if (pn < 10) {
            const bool isq = pn < 6; const int tq = isq ? pn - 2 : pn - 6; bf16_t* dst = (bf16_t*)(ws + (isq ? WS_Q : WS_K)); const float sc = isq ? C2 : 1.0f;
            const int hc = 4 * tq + wc, d0 = 8 * fq;
#pragma unroll
            for (int ai = 0; ai < 2; ++ai)
#pragma unroll
                for (int m = 0; m < 4; ++m) { const int row = row0 + ai * HALF + m * 16, pos = row & (SEQ - 1);
                    const f32x4 c0 = *(const f32x4*)(COS + pos * 32 + d0), c1 = *(const f32x4*)(COS + pos * 32 + d0 + 4);
                    const f32x4 s0 = *(const f32x4*)(SIN + pos * 32 + d0), s1 = *(const f32x4*)(SIN + pos * 32 + d0 + 4);
                    const f32x4 x10 = acc[ai][0][m][0], x11 = acc[ai][0][m][1], x20 = acc[ai][1][m][0], x21 = acc[ai][1][m][1];
                    const f32x4 o10 = (x10 * c0 - x20 * s0) * sc, o11 = (x11 * c1 - x21 * s1) * sc, o20 = (x20 * c0 + x10 * s0) * sc, o21 = (x21 * c1 + x11 * s1) * sc;
                    bf16_t* rp = dst + (size_t)row * DATT + hc * 64 + d0;
                    u32x4 w; w.x = pk2(o10[0], o10[1]); w.y = pk2(o10[2], o10[3]); w.z = pk2(o11[0], o11[1]); w.w = pk2(o11[2], o11[3]); *(u32x4*)rp = w;
                    w.x = pk2(o20[0], o20[1]); w.y = pk2(o20[2], o20[3]); w.z = pk2(o21[0], o21[1]); w.w = pk2(o21[2], o21[3]); *(u32x4*)(rp + 32) = w; }
        } else if (pn < 20) {
            bf16_t* dst; int pitch, colt;
            if (pn < 14) { dst = (bf16_t*)(ws + WS_V); pitch = DATT; colt = (pn - 10) * 256; }
            else { const int which = (pn - 14) >> 1; dst = (bf16_t*)(ws + WS_BG + (size_t)which * (WS_CG - WS_BG)); pitch = DCONV; colt = ((pn - 14) & 1) * 256; }
#pragma unroll
            for (int ai = 0; ai < 2; ++ai)
#pragma unroll
                for (int m = 0; m < 4; ++m) { bf16_t* rp = dst + (size_t)(row0 + ai * HALF + m * 16) * pitch + colt + cl0;
#pragma unroll
                    for (int bj = 0; bj < 2; ++bj) { const f32x4 v0 = acc[ai][bj][m][0], v1 = acc[ai][bj][m][1];
                        u32x4 w; w.x = pk2(v0[0], v0[1]); w.y = pk2(v0[2], v0[3]); w.z = pk2(v1[0], v1[1]); w.w = pk2(v1[2], v1[3]); *(u32x4*)(rp + bj * HALF) = w; } }
        } else {
            const int gc0 = (pn - 20) * 256 + cl0;
            f32x4 bv[2][2];
#pragma unroll
            for (int bj = 0; bj < 2; ++bj)
#pragma unroll
                for (int n = 0; n < 2; ++n) bv[bj][n] = *(const f32x4*)(bgate + gc0 + bj * HALF + 4 * n);
#pragma unroll
            for (int ai = 0; ai < 2; ++ai)
#pragma unroll
                for (int m = 0; m < 4; ++m) { unsigned char* rp = (unsigned char*)GATE + (size_t)(row0 + ai * HALF + m * 16) * NGATE + gc0;
#pragma unroll
                    for (int bj = 0; bj < 2; ++bj) { const f32x4 v0 = acc[ai][bj][m][0] + bv[bj][0], v1 = acc[ai][bj][m][1] + bv[bj][1];
                        u32x2 w;
                        w.x = (unsigned)(sigmoidf_(v0[0]) * 255.0f + 0.5f) | ((unsigned)(sigmoidf_(v0[1]) * 255.0f + 0.5f) << 8) | ((unsigned)(sigmoidf_(v0[2]) * 255.0f + 0.5f) << 16) | ((unsigned)(sigmoidf_(v0[3]) * 255.0f + 0.5f) << 24);
                        w.y = (unsigned)(sigmoidf_(v1[0]) * 255.0f + 0.5f) | ((unsigned)(sigmoidf_(v1[1]) * 255.0f + 0.5f) << 8) | ((unsigned)(sigmoidf_(v1[2]) * 255.0f + 0.5f) << 16) | ((unsigned)(sigmoidf_(v1[3]) * 255.0f + 0.5f) << 24);
                        *(u32x2*)(rp + bj * HALF) = w; } }
        }
    }
};
struct EpiGLU {
    static constexpr bool PERM = true, HOOK = false; const bf16_t* YG; bf16_t* YA; const float* bias;
    DI void operator()(const Acc& acc, const Unit& u, int wr, int wc, int fr, int fq) const {
        const int row0 = u.pm * BM + wr * 64 + fr, col0 = u.pn * BM + wc * 32 + 8 * fq;
        f32x4 bv[2][2];
#pragma unroll
        for (int bj = 0; bj < 2; ++bj) { bv[bj][0] = *(const f32x4*)(bias + col0 + bj * HALF); bv[bj][1] = *(const f32x4*)(bias + col0 + bj * HALF + 4); }
        u32x4 cur[2], nxt[2];
#define EG_LOAD(dstv, g) do { const size_t off_ = (size_t)(row0 + ((g) >> 2) * HALF + ((g) & 3) * 16) * DSSM + col0; dstv[0] = *(const u32x4*)(YG + off_); dstv[1] = *(const u32x4*)(YG + off_ + HALF); } while (0)
        EG_LOAD(cur, 0);
#pragma unroll
        for (int g = 0; g < 8; ++g) {
            if (g < 7) EG_LOAD(nxt, g + 1);
            const size_t off = (size_t)(row0 + (g >> 2) * HALF + (g & 3) * 16) * DSSM + col0;
#pragma unroll
            for (int bj = 0; bj < 2; ++bj) { const u32x4 y = cur[bj];
                const f32x4 v0 = acc[g >> 2][bj][g & 3][0] + bv[bj][0], v1 = acc[g >> 2][bj][g & 3][1] + bv[bj][1];
                u32x4 w; w.x = pk2(bflo(y.x) * sigmoidf_(v0[0]), bfhi(y.x) * sigmoidf_(v0[1])); w.y = pk2(bflo(y.y) * sigmoidf_(v0[2]), bfhi(y.y) * sigmoidf_(v0[3]));
                w.z = pk2(bflo(y.z) * sigmoidf_(v1[0]), bfhi(y.z) * sigmoidf_(v1[1])); w.w = pk2(bflo(y.w) * sigmoidf_(v1[2]), bfhi(y.w) * sigmoidf_(v1[3]));
                *(u32x4*)(YA + (size_t)(row0 + (g >> 2) * HALF + (g & 3) * 16) * DM + col0 + bj * HALF) = w; }
            cur[0] = nxt[0]; cur[1] = nxt[1];
        }
#undef EG_LOAD
    }
};
template <int IDX> struct EpiBranch {
    static constexpr bool PERM = true, HOOK = false; const bf16_t* GATE; float* MF; bf16_t* MB;
    DI void operator()(const Acc& acc, const Unit& u, int wr, int wc, int fr, int fq) const {
        const int row0 = u.pm * BM + wr * 64 + fr, col0 = u.pn * BM + wc * 32 + 8 * fq;
        u32x2 gcur[2], gnxt[2]; u32x4 mcur[2], mnxt[2];
#define EB_LOAD(gd, md, g) do { const int row_ = row0 + ((g) >> 2) * HALF + ((g) & 3) * 16; \
        _Pragma("unroll") for (int bj_ = 0; bj_ < 2; ++bj_) { gd[bj_] = *(const u32x2*)((const unsigned char*)GATE + (size_t)row_ * NGATE + IDX * DM + col0 + bj_ * HALF); \
            if (IDX > 0) md[bj_] = *(const u32x4*)(MB + (size_t)row_ * DM + col0 + bj_ * HALF); } } while (0)
        EB_LOAD(gcur, mcur, 0);
#pragma unroll
        for (int g = 0; g < 8; ++g) {
            if (g < 7) EB_LOAD(gnxt, mnxt, g + 1);
            const int row = row0 + (g >> 2) * HALF + (g & 3) * 16;
#pragma unroll
            for (int bj = 0; bj < 2; ++bj) { const int col = col0 + bj * HALF; const u32x2 gw = gcur[bj]; constexpr float I255 = 1.0f / 255.0f;
                f32x4 v0 = acc[g >> 2][bj][g & 3][0] * I255, v1 = acc[g >> 2][bj][g & 3][1] * I255;
                v0[0] *= (float)(gw.x & 255u); v0[1] *= (float)((gw.x >> 8) & 255u); v0[2] *= (float)((gw.x >> 16) & 255u); v0[3] *= (float)(gw.x >> 24);
                v1[0] *= (float)(gw.y & 255u); v1[1] *= (float)((gw.y >> 8) & 255u); v1[2] *= (float)((gw.y >> 16) & 255u); v1[3] *= (float)(gw.y >> 24);
                if (IDX > 0) { const u32x4 pm_ = mcur[bj];
                    v0[0] += bflo(pm_.x); v0[1] += bfhi(pm_.x); v0[2] += bflo(pm_.y); v0[3] += bfhi(pm_.y);
                    v1[0] += bflo(pm_.z); v1[1] += bfhi(pm_.z); v1[2] += bflo(pm_.w); v1[3] += bfhi(pm_.w); }
                u32x4 w; w.x = pk2(v0[0], v0[1]); w.y = pk2(v0[2], v0[3]); w.z = pk2(v1[0], v1[1]); w.w = pk2(v1[2], v1[3]);
                *(u32x4*)(MB + (size_t)row * DM + col) = w; }
            gcur[0] = gnxt[0]; gcur[1] = gnxt[1];
            if (IDX > 0) { mcur[0] = mnxt[0]; mcur[1] = mnxt[1]; }
        }
#undef EB_LOAD
    }
};
struct EpiBranchAll {
    static constexpr bool PERM = true, HOOK = true; const unsigned char* GATE; bf16_t* MB;
    DI void hook(Acc& acc, const Unit& u, int seg, int wr, int wc, int fr, int fq) const {
        const int row0 = u.pm * BM + wr * 64 + fr, col0 = u.pn * BM + wc * 32 + 8 * fq;
        const unsigned lo = (seg == 1) ? 1u : 0u;
#pragma unroll
        for (int g = 0; g < 8; ++g) { const size_t go = (size_t)(row0 + (g >> 2) * HALF + (g & 3) * 16) * NGATE + seg * DM + col0;
#pragma unroll
            for (int bj = 0; bj < 2; ++bj) { const u32x2 qa = *(const u32x2*)(GATE + go + bj * HALF), qb = *(const u32x2*)(GATE + go + DM + bj * HALF);
#pragma unroll
                for (int e = 0; e < 4; ++e) { unsigned a0 = (qa.x >> (8 * e)) & 255u, a1 = (qa.y >> (8 * e)) & 255u, b0 = (qb.x >> (8 * e)) & 255u, b1 = (qb.y >> (8 * e)) & 255u;
                    a0 = a0 < lo ? lo : a0; a1 = a1 < lo ? lo : a1; b0 = b0 < 1u ? 1u : b0; b1 = b1 < 1u ? 1u : b1;
                    acc[g >> 2][bj][g & 3][0][e] *= (float)a0 * __builtin_amdgcn_rcpf((float)b0);
                    acc[g >> 2][bj][g & 3][1][e] *= (float)a1 * __builtin_amdgcn_rcpf((float)b1); } }
            asm volatile("" ::: "memory"); }
    }
    DI void operator()(Acc& acc, const Unit& u, int wr, int wc, int fr, int fq) const {
        if (u.seg < 2) { hook(acc, u, u.seg, wr, wc, fr, fq); return; }
        const int row0 = u.pm * BM + wr * 64 + fr, col0 = u.pn * BM + wc * 32 + 8 * fq;
#pragma unroll
        for (int g = 0; g < 8; ++g) { const int row = row0 + (g >> 2) * HALF + (g & 3) * 16;
#pragma unroll
            for (int bj = 0; bj < 2; ++bj) { const u32x2 qc = *(const u32x2*)(GATE + (size_t)row * NGATE + 2 * DM + col0 + bj * HALF); constexpr float I255 = 1.0f / 255.0f;
                f32x4 v0 = acc[g >> 2][bj][g & 3][0] * I255, v1 = acc[g >> 2][bj][g & 3][1] * I255;
#pragma unroll
                for (int e = 0; e < 4; ++e) { unsigned c0 = (qc.x >> (8 * e)) & 255u, c1 = (qc.y >> (8 * e)) & 255u; c0 = c0 < 1u ? 1u : c0; c1 = c1 < 1u ? 1u : c1; v0[e] *= (float)c0; v1[e] *= (float)c1; }
                u32x4 w; w.x = pk2(v0[0], v0[1]); w.y = pk2(v0[2], v0[3]); w.z = pk2(v1[0], v1[1]); w.w = pk2(v1[2], v1[3]);
                *(u32x4*)(MB + (size_t)row * DM + col0 + bj * HALF) = w; } }
    }
};
}

DI void transpose_item(const float* W, int ldw, int K, bf16_t* WT, LAS float* scr, int k0, int nsrc0, int ndst0, int lane) {
#pragma unroll 8
    for (int i = 0; i < 32; ++i) { const int kk = 2 * i + (lane >> 5); scr[kk * 33 + (lane & 31)] = W[(size_t)(k0 + kk) * ldw + nsrc0 + (lane & 31)]; }
    LDS_WAIT();
    const int c = lane & 7;
#pragma unroll
    for (int j = 0; j < 4; ++j) { const int n = (lane >> 3) + 8 * j; const LAS float* s = scr + (8 * c) * 33 + n;
        u32x4 o; o.x = pk2(s[0 * 33], s[1 * 33]); o.y = pk2(s[2 * 33], s[3 * 33]); o.z = pk2(s[4 * 33], s[5 * 33]); o.w = pk2(s[6 * 33], s[7 * 33]);
        *(u32x4*)(WT + (size_t)(ndst0 + n) * K + k0 + 8 * c) = o; }
    LDS_WAIT();
}
DI void conv_matrix(const float* W, int ldw, int K, int Ndst, bf16_t* WT, int kind, int gw, int NGW, LAS float* scr, int lane) {
    const int nblk = Ndst / 32, nitems = (K / 64) * nblk;
    for (int it = gw; it < nitems; it += NGW) {
        const int kb = it / nblk, nb = it - kb * nblk, n = 32 * nb; int src = n;
        if (kind == 1) { const int pn = n >> 8, r = n & 255; src = (r < 128) ? 128 * pn + r : DFF + 128 * pn + (r - 128); }
        else if (kind == 2) { if (n >= 512 && n < 2560) { const int n1 = n - 512, t = n1 >> 8, r = n1 & 255, half = r >> 7, i = r & 127, hcl = i >> 5; src = 512 + 256 * t + 64 * hcl + 32 * half; } }
        transpose_item(W, ldw, K, WT, scr, 64 * kb, src, n, lane);
    }
}

template <bool OUT_F32>
DI void norm_rows(const float* X, const float* g, void* out, int gw, int NGW, int lane) {
    for (int m = gw; m < M; m += NGW) {
        const f32x4* xr = (const f32x4*)(X + (size_t)m * DM) + lane;
        f32x4 v[8]; float s = 0.f;
#pragma unroll
        for (int j = 0; j < 8; ++j) { v[j] = xr[64 * j]; s += (v[j][0] * v[j][0] + v[j][1] * v[j][1]) + (v[j][2] * v[j][2] + v[j][3] * v[j][3]); }
        f32x4 gvv[8];
#pragma unroll
        for (int j = 0; j < 8; ++j) gvv[j] = ((const f32x4*)g)[64 * j + lane];
        const float r = 1.0f / sqrtf(wave_sum(s) * (1.0f / DM) + 1e-6f);
#pragma unroll
        for (int j = 0; j < 8; ++j) { const f32x4 o = v[j] * r * gvv[j];
            if (OUT_F32) ((f32x4*)((float*)out + (size_t)m * DM))[64 * j + lane] = o;
            else { u32x2 w; w.x = pk2(o[0], o[1]); w.y = pk2(o[2], o[3]); ((u32x2*)((bf16_t*)out + (size_t)m * DM))[64 * j + lane] = w; } }
    }
}

template <bool OUT_F32>
DI void norm_rows_b(const bf16_t* X, const float* g, void* out, int gw, int NGW, int lane) {
    for (int m = gw; m < M; m += NGW) {
        const u32x4* xr = (const u32x4*)(X + (size_t)m * DM) + lane;
        u32x4 w[4]; float s = 0.f;
#pragma unroll
        for (int j = 0; j < 4; ++j) w[j] = xr[64 * j];
        f32x4 gv[4][2];
#pragma unroll
        for (int j = 0; j < 4; ++j) { gv[j][0] = ((const f32x4*)g)[2 * (64 * j + lane)]; gv[j][1] = ((const f32x4*)g)[2 * (64 * j + lane) + 1]; }
        f32x4 v[4][2];
#pragma unroll
        for (int j = 0; j < 4; ++j) { v[j][0] = (f32x4){bflo(w[j].x), bfhi(w[j].x), bflo(w[j].y), bfhi(w[j].y)}; v[j][1] = (f32x4){bflo(w[j].z), bfhi(w[j].z), bflo(w[j].w), bfhi(w[j].w)};
#pragma unroll
            for (int q = 0; q < 2; ++q) s += (v[j][q][0] * v[j][q][0] + v[j][q][1] * v[j][q][1]) + (v[j][q][2] * v[j][q][2] + v[j][q][3] * v[j][q][3]); }
        const float r = 1.0f / sqrtf(wave_sum(s) * (1.0f / DM) + 1e-6f);
#pragma unroll
        for (int j = 0; j < 4; ++j) { const f32x4 o0 = v[j][0] * r * gv[j][0], o1 = v[j][1] * r * gv[j][1];
            if (OUT_F32) { f32x4* op = (f32x4*)((float*)out + (size_t)m * DM) + 2 * (64 * j + lane); op[0] = o0; op[1] = o1; }
            else { u32x4 ow; ow.x = pk2(o0[0], o0[1]); ow.y = pk2(o0[2], o0[3]); ow.z = pk2(o1[0], o1[1]); ow.w = pk2(o1[2], o1[3]); ((u32x4*)((bf16_t*)out + (size_t)m * DM))[64 * j + lane] = ow; } }
    }
}

constexpr int KP = 272, VP = 288, ATT_STAGE = 64 * KP + 64 * VP, ATT_X = 2 * ATT_STAGE;
static_assert(ATT_X + 65536 <= LDS_BYTES, "attention LDS");
#define MFMA32(a, b, c) __builtin_amdgcn_mfma_f32_32x32x16_bf16((a), (b), (c), 0, 0, 0)
typedef short v4i16_t __attribute__((ext_vector_type(4)));
DI s16x4 vtr(const LAS unsigned char* p) { return __builtin_bit_cast(s16x4, __builtin_amdgcn_ds_read_tr16_b64_v4i16((LAS v4i16_t*)p)); }

template <bool QK, bool PV>
DI void att_step(int t, LAS unsigned char* lds, const bf16_t* kg, const bf16_t* vg, int srow, int sch, int r, int h, int c, int voff0,
                 const bf16x8 (&qf)[4], f32x16 (&O)[4], bf16x8 (&pf)[4], float& mrun, float& lrun) {
    const LAS unsigned char* kbase = lds + (t & 1) * (64 * KP);
    const LAS unsigned char* vbase = lds + 2 * 64 * KP + ((t - 1) & 1) * (64 * VP);
    u32x4 kr[2], vr[2];
    const bool ldk = QK && (t + 1 < 64);
    if (ldk) {
#pragma unroll
        for (int i = 0; i < 2; ++i) kr[i] = *(const u32x4*)(kg + (size_t)((t + 1) * 64 + i * 32) * DATT);
    }
    if (QK) {
#pragma unroll
        for (int i = 0; i < 2; ++i) vr[i] = *(const u32x4*)(vg + (size_t)(t * 64 + i * 32) * DATT);
    }
    f32x16 S[2]; bf16x8 pfn[4]; s16x4 vA[4][2], vB[4][2];
#define VFRAG_LOAD(dstv, dt_) do { _Pragma("unroll") for (int kk_ = 0; kk_ < 4; ++kk_) { \
        const LAS unsigned char* vp_ = vbase + voff0 + (16 * kk_) * VP + 64 * (dt_); dstv[kk_][0] = vtr(vp_); dstv[kk_][1] = vtr(vp_ + 8 * VP); } } while (0)
#define PV_MMA(srcv, dt_) do { _Pragma("unroll") for (int kk_ = 0; kk_ < 4; ++kk_) { \
        const bf16x8 vf_ = __builtin_shufflevector(srcv[kk_][0], srcv[kk_][1], 0, 1, 2, 3, 4, 5, 6, 7); O[dt_] = MFMA32(vf_, pf[kk_], O[dt_]); } } while (0)
    if (QK) {
        bf16x8 kf[2][4];
#pragma unroll
        for (int kti = 0; kti < 2; ++kti)
#pragma unroll
            for (int ks = 0; ks < 4; ++ks) kf[kti][ks] = *(const LAS bf16x8*)(kbase + (32 * kti + r) * KP + c * 128 + (16 * ks + 8 * h) * 2);
        if (PV) VFRAG_LOAD(vA, 0);
        __builtin_amdgcn_sched_barrier(0);
#pragma unroll
        for (int kti = 0; kti < 2; ++kti)
#pragma unroll
            for (int ks = 0; ks < 4; ++ks) { if (ks == 0) { f32x16 z; _Pragma("unroll") for (int i = 0; i < 16; ++i) z[i] = 0.f; S[kti] = MFMA32(kf[kti][ks], qf[ks], z); } else S[kti] = MFMA32(kf[kti][ks], qf[ks], S[kti]); }
        float tm0 = fmaxf(fmaxf(S[0][0], S[0][1]), S[0][2]), tm1 = fmaxf(fmaxf(S[1][0], S[1][1]), S[1][2]);
#pragma unroll
        for (int i = 3; i < 15; i += 2) { tm0 = fmaxf(fmaxf(tm0, S[0][i]), S[0][i + 1]); tm1 = fmaxf(fmaxf(tm1, S[1][i]), S[1][i + 1]); }
        float tmax = fmaxf(fmaxf(tm0, tm1), fmaxf(S[0][15], S[1][15]));
        if (!PV || __builtin_amdgcn_ballot_w64(tmax > mrun + 8.0f) != 0ull) {
            tmax = fmaxf(tmax, __shfl_xor(tmax, 32));
            const float mnew = !PV ? tmax : fmaxf(tmax, mrun);
            const float alpha = !PV ? 1.0f : __builtin_amdgcn_exp2f(mrun - mnew);
            mrun = mnew; lrun *= alpha;
            if (PV) {
#pragma unroll
                for (int dt = 0; dt < 4; ++dt)
#pragma unroll
                    for (int i = 0; i < 16; ++i) O[dt][i] *= alpha;
#pragma unroll
                for (int kk = 0; kk < 4; ++kk) { u32x4 w = __builtin_bit_cast(u32x4, pf[kk]);
                    w.x = pk2(bflo(w.x) * alpha, bfhi(w.x) * alpha); w.y = pk2(bflo(w.y) * alpha, bfhi(w.y) * alpha); w.z = pk2(bflo(w.z) * alpha, bfhi(w.z) * alpha); w.w = pk2(bflo(w.w) * alpha, bfhi(w.w) * alpha);
                    pf[kk] = __builtin_bit_cast(bf16x8, w); }
            }
        }
        __builtin_amdgcn_sched_barrier(0);
    } else {
        VFRAG_LOAD(vA, 0);
    }
    if (PV) VFRAG_LOAD(vB, 1);
    if (QK) {
        f32x2_t ls2 = {0.f, 0.f};
#pragma unroll
        for (int kti = 0; kti < 2; ++kti)
#pragma unroll
            for (int i = 0; i < 16; i += 2) { f32x2_t p2; p2.x = __builtin_amdgcn_exp2f(S[kti][i] - mrun); p2.y = __builtin_amdgcn_exp2f(S[kti][i + 1] - mrun); S[kti][i] = p2.x; S[kti][i + 1] = p2.y; ls2 += p2; }
        lrun += ls2.x + ls2.y;
#pragma unroll
        for (int kk = 0; kk < 4; ++kk) { const int kti = kk >> 1, s = kk & 1; u32x4 w; w.x = pk2(S[kti][8 * s + 0], S[kti][8 * s + 1]); w.y = pk2(S[kti][8 * s + 2], S[kti][8 * s + 3]);
            w.z = pk2(S[kti][8 * s + 4], S[kti][8 * s + 5]); w.w = pk2(S[kti][8 * s + 6], S[kti][8 * s + 7]); pfn[kk] = __builtin_bit_cast(bf16x8, w); }
    }
    if (PV) {
        PV_MMA(vA, 0); VFRAG_LOAD(vA, 2); PV_MMA(vB, 1); VFRAG_LOAD(vB, 3); PV_MMA(vA, 2); PV_MMA(vB, 3);
    }
#ifdef ATT_INTERLEAVE
    if (QK && PV) {
        __builtin_amdgcn_sched_group_barrier(0x100, 8, 0);
#pragma unroll
        for (int gi = 0; gi < 16; ++gi) { __builtin_amdgcn_sched_group_barrier(0x008, 1, 0); __builtin_amdgcn_sched_group_barrier(0x402, 6, 0); if (gi == 1 || gi == 5) __builtin_amdgcn_sched_group_barrier(0x100, 8, 0); }
    }
#endif
    __builtin_amdgcn_sched_barrier(0);
    if (QK) {
#pragma unroll
        for (int kk = 0; kk < 4; ++kk) pf[kk] = pfn[kk];
        LAS unsigned char* nk = lds + ((t + 1) & 1) * (64 * KP); LAS unsigned char* nv = lds + 2 * 64 * KP + (t & 1) * (64 * VP);
        if (ldk) {
#pragma unroll
            for (int i = 0; i < 2; ++i) *(LAS u32x4*)(nk + (srow + 32 * i) * KP + sch * 16) = kr[i];
        }
#pragma unroll
        for (int i = 0; i < 2; ++i) *(LAS u32x4*)(nv + (srow + 32 * i) * VP + sch * 16) = vr[i];
    }
    __syncthreads();
#undef VFRAG_LOAD
#undef PV_MMA
}

DI void attn_phase(LAS unsigned char* lds, const bf16_t* Q, const bf16_t* K, const bf16_t* V, bf16_t* YB, const float* lamvec, const float* subln, float lambda_init, int vcu, int G) {
    int tid_ = threadIdx.x; asm volatile("" : "+v"(tid_));
    const int tid = tid_, lane = tid & 63, wave = __builtin_amdgcn_readfirstlane(tid >> 6), r = lane & 31, h = lane >> 5, qs = wave & 3, c = wave >> 2;
    const float lam = __expf(wave_sum(lamvec[lane] * lamvec[64 + lane])) - __expf(wave_sum(lamvec[128 + lane] * lamvec[192 + lane])) + lambda_init;
    const int srow = tid >> 4, sch = tid & 15;
    const int tq = (lane & 15) >> 2, tp = lane & 3, blk = (lane >> 4) & 1;
    for (int item = vcu; item < 512; item += G) {
        const int pair = item >> 5, qb = item & 31, b = pair >> 3, hd = pair & 7;
        const int rowq = b * SEQ + qb * 128 + qs * 32 + r;
        bf16x8 qf[4];
#pragma unroll
        for (int ks = 0; ks < 4; ++ks) qf[ks] = *(const bf16x8*)(Q + (size_t)rowq * DATT + hd * 128 + c * 64 + 16 * ks + 8 * h);
        f32x16 O[4];
#pragma unroll
        for (int dt = 0; dt < 4; ++dt)
#pragma unroll
            for (int i = 0; i < 16; ++i) O[dt][i] = 0.f;
        float mrun = 0.f, lrun = 0.f;
        const bf16_t* kg = K + (size_t)(b * SEQ + srow) * DATT + hd * 128 + sch * 8;
        const bf16_t* vg = V + (size_t)(b * SEQ + srow) * DATT + hd * 128 + sch * 8;
        u32x4 kr[2], vr[2];
#pragma unroll
        for (int i = 0; i < 2; ++i) kr[i] = *(const u32x4*)(kg + (size_t)(i * 32) * DATT);
#pragma unroll
        for (int i = 0; i < 2; ++i) *(LAS u32x4*)(lds + (srow + 32 * i) * KP + sch * 16) = kr[i];
        __syncthreads();
        bf16x8 pf[4];
#pragma unroll
        for (int i = 0; i < 4; ++i) pf[i] = (bf16x8){0, 0, 0, 0, 0, 0, 0, 0};
        const int voff0 = (4 * h + tq) * VP + (16 * blk) * 2 + 8 * tp;
        att_step<true, false>(0, lds, kg, vg, srow, sch, r, h, c, voff0, qf, O, pf, mrun, lrun);
        for (int t = 1; t < 64; ++t) att_step<true, true>(t, lds, kg, vg, srow, sch, r, h, c, voff0, qf, O, pf, mrun, lrun);
        att_step<false, true>(64, lds, kg, vg, srow, sch, r, h, c, voff0, qf, O, pf, mrun, lrun);
        const float ltot = lrun + __shfl_xor(lrun, 32), inv = 1.0f / ltot;
        LAS float* X = (LAS float*)(lds + ATT_X + qs * 16384);
        if (c == 1) { const float sc = lam * inv;
#pragma unroll
            for (int dt = 0; dt < 4; ++dt)
#pragma unroll
                for (int i = 0; i < 16; ++i) X[(dt * 16 + i) * 64 + lane] = O[dt][i] * sc; }
        __syncthreads();
        if (c == 0) {
            float ss = 0.f;
#pragma unroll
            for (int dt = 0; dt < 4; ++dt)
#pragma unroll
                for (int i = 0; i < 16; ++i) { const float o = O[dt][i] * inv - X[(dt * 16 + i) * 64 + lane]; O[dt][i] = o; ss += o * o; }
            ss += __shfl_xor(ss, 32);
            const float rn = (1.0f / sqrtf(ss * (1.0f / 128.0f) + 1e-6f)) * (1.0f - lambda_init);
            bf16_t* op = YB + (size_t)rowq * DM + hd * 128;
#pragma unroll
            for (int dt = 0; dt < 4; ++dt)
#pragma unroll
                for (int g4 = 0; g4 < 4; ++g4) { const int d = 32 * dt + 8 * g4 + 4 * h; const f32x4 gv = *(const f32x4*)(subln + d);
                    u32x2 w; w.x = pk2(O[dt][4 * g4 + 0] * rn * gv[0], O[dt][4 * g4 + 1] * rn * gv[1]); w.y = pk2(O[dt][4 * g4 + 2] * rn * gv[2], O[dt][4 * g4 + 3] * rn * gv[3]);
                    *(u32x2*)(op + d) = w; }
        }
        __syncthreads();
    }
}

constexpr int S5_WAVE_LDS = 12800, S5_SP = 132;
struct S5Par { float ar, ai, cr, ci; };
DI S5Par s5_par(const float* lre, const float* lim, const float* ldt, int dir, int g, int n) {
    const float dt = expf(ldt[dir * 32 + g]), lr = lre[(dir * 32 + g) * 64 + n], li = lim[(dir * 32 + g) * 64 + n];
    const float mag = expf(dt * lr); S5Par p; p.ar = mag * cosf(dt * li); p.ai = mag * sinf(dt * li);
    const float den = lr * lr + li * li, nr = p.ar - 1.0f; p.cr = (nr * lr + p.ai * li) / den; p.ci = (p.ai * lr - nr * li) / den; return p;
}
DI void s5_load_u(LAS float* us, const float* U, int b, int g, int c, int lane) {
    const u32x4* up = (const u32x4*)((const bf16_t*)U + (size_t)(b * SEQ + c * 64 + lane) * DSSM + g * 16);
#pragma unroll
    for (int j = 0; j < 2; ++j) { const u32x4 w = up[j];
        *(LAS f32x4*)(us + lane * 16 + 8 * j) = (f32x4){bflo(w.x), bfhi(w.x), bflo(w.y), bfhi(w.y)}; *(LAS f32x4*)(us + lane * 16 + 8 * j + 4) = (f32x4){bflo(w.z), bfhi(w.z), bflo(w.w), bfhi(w.w)}; }
    LDS_WAIT(); __builtin_amdgcn_wave_barrier();
}
DI void s5_bu(const LAS float* us, int t, const float (&Bre)[16], const float (&Bim)[16], float& bur, float& bui) {
    float r0 = 0.f, r1 = 0.f, i0 = 0.f, i1 = 0.f;
#pragma unroll
    for (int j = 0; j < 4; ++j) { const f32x4 u = *(const LAS f32x4*)(us + t * 16 + 4 * j);
        r0 += u[0] * Bre[4 * j + 0]; r1 += u[1] * Bre[4 * j + 1]; r0 += u[2] * Bre[4 * j + 2]; r1 += u[3] * Bre[4 * j + 3];
        i0 += u[0] * Bim[4 * j + 0]; i1 += u[1] * Bim[4 * j + 1]; i0 += u[2] * Bim[4 * j + 2]; i1 += u[3] * Bim[4 * j + 3]; }
    bur = r0 + r1; bui = i0 + i1;
}
struct URow { f32x4 v[4]; };
DI URow s5_ldu(const LAS float* us, int t) { URow u;
#pragma unroll
    for (int j = 0; j < 4; ++j) u.v[j] = *(const LAS f32x4*)(us + t * 16 + 4 * j);
    return u; }
DI void s5_bu_r(const URow& u, const float (&Bre)[16], const float (&Bim)[16], float& bur, float& bui) {
    float r0 = 0.f, r1 = 0.f, i0 = 0.f, i1 = 0.f;
#pragma unroll
    for (int j = 0; j < 4; ++j) {
        r0 += u.v[j][0] * Bre[4 * j + 0]; r1 += u.v[j][1] * Bre[4 * j + 1]; r0 += u.v[j][2] * Bre[4 * j + 2]; r1 += u.v[j][3] * Bre[4 * j + 3];
        i0 += u.v[j][0] * Bim[4 * j + 0]; i1 += u.v[j][1] * Bim[4 * j + 1]; i0 += u.v[j][2] * Bim[4 * j + 2]; i1 += u.v[j][3] * Bim[4 * j + 3]; }
    bur = r0 + r1; bui = i0 + i1;
}
DI void s5_pass1(LAS unsigned char* lds, const float* U, float* SE, const float* lre, const float* lim, const float* ldt, const float* bre, const float* bim, int gw, int NGW) {
    int tid_ = threadIdx.x; asm volatile("" : "+v"(tid_));
    const int lane = tid_ & 63, wave = __builtin_amdgcn_readfirstlane(tid_ >> 6);
    LAS float* us = (LAS float*)(lds + wave * S5_WAVE_LDS);
    for (int item = gw; item < 4096; item += NGW) {
        const int c = item & 63, bg = item >> 6, g = bg & 31, b = bg >> 5;
        const S5Par pf = s5_par(lre, lim, ldt, 0, g, lane), pb = s5_par(lre, lim, ldt, 1, g, lane);
        float Bre[16], Bim[16];
#pragma unroll
        for (int j = 0; j < 4; ++j) { const f32x4 a = *(const f32x4*)(bre + (size_t)(g * 64 + lane) * 16 + 4 * j), bb = *(const f32x4*)(bim + (size_t)(g * 64 + lane) * 16 + 4 * j);
#pragma unroll
            for (int e = 0; e < 4; ++e) { Bre[4 * j + e] = a[e]; Bim[4 * j + e] = bb[e]; } }
        s5_load_u(us, U, b, g, c, lane);
        float efr = 0.f, efi = 0.f, ebr = 0.f, ebi = 0.f, pwr = 1.f, pwi = 0.f;
#pragma unroll 4
        for (int t = 0; t < 64; ++t) {
            float bur, bui; s5_bu(us, t, Bre, Bim, bur, bui);
            const float fr_ = pf.cr * bur - pf.ci * bui, fi_ = pf.cr * bui + pf.ci * bur;
            const float nfr = pf.ar * efr - pf.ai * efi + fr_, nfi = pf.ar * efi + pf.ai * efr + fi_; efr = nfr; efi = nfi;
            const float br_ = pb.cr * bur - pb.ci * bui, bi_ = pb.cr * bui + pb.ci * bur;
            ebr += pwr * br_ - pwi * bi_; ebi += pwr * bi_ + pwi * br_;
            const float npr = pwr * pb.ar - pwi * pb.ai, npi = pwr * pb.ai + pwi * pb.ar; pwr = npr; pwi = npi;
        }
        float* se = SE + (size_t)item * 256 + lane; se[0] = efr; se[64] = efi; se[128] = ebr; se[192] = ebi;
        __builtin_amdgcn_wave_barrier();
    }
}
DI void s5_pass2(LAS unsigned char* lds, const float* U, const float* SE, bf16_t* YG, const float* lre, const float* lim, const float* ldt, const float* bre, const float* bim,
                 const float* cre, const float* cim, const float* dsk, int gw, int NGW) {
    int tid_ = threadIdx.x; asm volatile("" : "+v"(tid_));
    const int lane = tid_ & 63, wave = __builtin_amdgcn_readfirstlane(tid_ >> 6), l15 = lane & 15, l4 = lane >> 4;
    LAS float* us = (LAS float*)(lds + wave * S5_WAVE_LDS); LAS float* Ss = us + 1024;
    for (int item = gw; item < 4096; item += NGW) {
        const int c = item & 63, bg = item >> 6, g = bg & 31, b = bg >> 5;
        const S5Par pf = s5_par(lre, lim, ldt, 0, g, lane), pb = s5_par(lre, lim, ldt, 1, g, lane);
        float Bre[16], Bim[16], Cm[32];
#pragma unroll
        for (int j = 0; j < 4; ++j) { const f32x4 a = *(const f32x4*)(bre + (size_t)(g * 64 + lane) * 16 + 4 * j), bb = *(const f32x4*)(bim + (size_t)(g * 64 + lane) * 16 + 4 * j);
#pragma unroll
            for (int e = 0; e < 4; ++e) { Bre[4 * j + e] = a[e]; Bim[4 * j + e] = bb[e]; } }
#pragma unroll
        for (int m = 0; m < 16; ++m) { Cm[m] = cre[(size_t)(g * 16 + l15) * 64 + 4 * m + l4]; Cm[16 + m] = -cim[(size_t)(g * 16 + l15) * 64 + 4 * m + l4]; }
        s5_load_u(us, U, b, g, c, lane);
        float afr = pf.ar, afi = pf.ai, abr = pb.ar, abi = pb.ai;
#pragma unroll
        for (int i = 0; i < 6; ++i) { const float x = afr * afr - afi * afi, y = 2.f * afr * afi; afr = x; afi = y; const float z = abr * abr - abi * abi, w = 2.f * abr * abi; abr = z; abi = w; }
        float sfr = 0.f, sfi = 0.f, sbr = 0.f, sbi = 0.f;
        const float* seb = SE + (size_t)(bg * 64) * 256 + lane;
#pragma unroll 1
        for (int c8 = 0; c8 < 64; c8 += 8) {
            float er[8], ei[8], br[8], bi[8];
#pragma unroll
            for (int j = 0; j < 8; ++j) { er[j] = seb[(size_t)(c8 + j) * 256]; ei[j] = seb[(size_t)(c8 + j) * 256 + 64]; br[j] = seb[(size_t)(63 - c8 - j) * 256 + 128]; bi[j] = seb[(size_t)(63 - c8 - j) * 256 + 192]; }
#pragma unroll
            for (int j = 0; j < 8; ++j) {
                if (c8 + j < c) { const float x = afr * sfr - afi * sfi + er[j], y = afr * sfi + afi * sfr + ei[j]; sfr = x; sfi = y; }
                if (63 - c8 - j > c) { const float x = abr * sbr - abi * sbi + br[j], y = abr * sbi + abi * sbr + bi[j]; sbr = x; sbi = y; }
            }
        }
        f32x4 Y[4];
#pragma unroll
        for (int s = 0; s < 4; ++s) Y[s] = (f32x4){0.f, 0.f, 0.f, 0.f};
#pragma unroll
        for (int sub = 0; sub < 4; ++sub) {
            URow ucur = s5_ldu(us, 16 * sub);
#pragma unroll 4
            for (int tt = 0; tt < 16; ++tt) {
                const URow unxt = s5_ldu(us, (16 * sub + tt + 1) & 63);
                float bur, bui; s5_bu_r(ucur, Bre, Bim, bur, bui); ucur = unxt;
                const float fr_ = pf.cr * bur - pf.ci * bui, fi_ = pf.cr * bui + pf.ci * bur;
                const float x = pf.ar * sfr - pf.ai * sfi + fr_, y = pf.ar * sfi + pf.ai * sfr + fi_; sfr = x; sfi = y;
                Ss[tt * S5_SP + lane] = sfr; Ss[tt * S5_SP + 64 + lane] = sfi;
            }
            LDS_WAIT(); __builtin_amdgcn_wave_barrier();
#pragma unroll
            for (int m = 0; m < 32; ++m) { const float bv = Ss[l15 * S5_SP + 4 * m + l4]; Y[sub] = __builtin_amdgcn_mfma_f32_16x16x4f32(Cm[m], bv, Y[sub], 0, 0, 0); }
            LDS_WAIT(); __builtin_amdgcn_wave_barrier();
        }
#pragma unroll
        for (int sub = 3; sub >= 0; --sub) {
            URow ucur = s5_ldu(us, 16 * sub + 15);
#pragma unroll 4
            for (int tt = 15; tt >= 0; --tt) {
                const URow unxt = s5_ldu(us, (16 * sub + tt - 1) & 63);
                float bur, bui; s5_bu_r(ucur, Bre, Bim, bur, bui); ucur = unxt;
                const float br_ = pb.cr * bur - pb.ci * bui, bi_ = pb.cr * bui + pb.ci * bur;
                const float x = pb.ar * sbr - pb.ai * sbi + br_, y = pb.ar * sbi + pb.ai * sbr + bi_; sbr = x; sbi = y;
                Ss[tt * S5_SP + lane] = sbr; Ss[tt * S5_SP + 64 + lane] = sbi;
            }
            LDS_WAIT(); __builtin_amdgcn_wave_barrier();
#pragma unroll
            for (int m = 0; m < 32; ++m) { const float bv = Ss[l15 * S5_SP + 4 * m + l4]; Y[sub] = __builtin_amdgcn_mfma_f32_16x16x4f32(Cm[m], bv, Y[sub], 0, 0, 0); }
            LDS_WAIT(); __builtin_amdgcn_wave_barrier();
        }
        const f32x4 dv = *(const f32x4*)(dsk + g * 16 + 4 * l4);
#pragma unroll
        for (int sub = 0; sub < 4; ++sub) { const int t = 16 * sub + l15; const f32x4 uv = *(const LAS f32x4*)(us + t * 16 + 4 * l4);
            float y[4];
#pragma unroll
            for (int v = 0; v < 4; ++v) y[v] = gelu_tanh(Y[sub][v] + dv[v] * uv[v]);
            u32x2 w; w.x = pk2(y[0], y[1]); w.y = pk2(y[2], y[3]);
            *(u32x2*)(YG + (size_t)(b * SEQ + c * 64 + t) * DSSM + g * 16 + 4 * l4) = w; }
        LDS_WAIT(); __builtin_amdgcn_wave_barrier();
    }
}

DI void conv_phase(const bf16_t* BG, const bf16_t* CG, const bf16_t* XV, const float* cw, bf16_t* YC, int gt, int NT) {
    for (int idx = gt; idx < M * 64; idx += NT) {
        const int row = idx >> 6, ch = (idx & 63) * 8, t = row & (SEQ - 1);
        const size_t o = (size_t)row * DCONV + ch;
        const u32x4 zero = {0u, 0u, 0u, 0u};
        const u32x4 c1 = *(const u32x4*)(CG + o), x1 = *(const u32x4*)(XV + o), bgv = *(const u32x4*)(BG + o);
        const u32x4 c0 = t > 0 ? *(const u32x4*)(CG + o - DCONV) : zero, x0 = t > 0 ? *(const u32x4*)(XV + o - DCONV) : zero;
        const u32x4 c2 = t < SEQ - 1 ? *(const u32x4*)(CG + o + DCONV) : zero, x2 = t < SEQ - 1 ? *(const u32x4*)(XV + o + DCONV) : zero;
        float y[8];
#pragma unroll
        for (int j = 0; j < 4; ++j) {
            const float w0a = cw[ch + 2 * j], w0b = cw[ch + 2 * j + 1], w1a = cw[DCONV + ch + 2 * j], w1b = cw[DCONV + ch + 2 * j + 1], w2a = cw[2 * DCONV + ch + 2 * j], w2b = cw[2 * DCONV + ch + 2 * j + 1];
            y[2 * j] = bflo(bgv[j]) * (w0a * bflo(c0[j]) * bflo(x0[j]) + w1a * bflo(c1[j]) * bflo(x1[j]) + w2a * bflo(c2[j]) * bflo(x2[j]));
            y[2 * j + 1] = bfhi(bgv[j]) * (w0b * bfhi(c0[j]) * bfhi(x0[j]) + w1b * bfhi(c1[j]) * bfhi(x1[j]) + w2b * bfhi(c2[j]) * bfhi(x2[j]));
        }
        u32x4 w; w.x = pk2(y[0], y[1]); w.y = pk2(y[2], y[3]); w.z = pk2(y[4], y[5]); w.w = pk2(y[6], y[7]);
        *(u32x4*)(YC + (size_t)row * DM + ch) = w;
    }
}

#define XB_TMO      128
#define XB_XCNT(j)  (256  + 64 * (j))
#define XB_XSUB(j)  (1280 + 64 * (j))
#define XB_XGEN(j)  (2304 + 64 * (j))
#define XB_TOP      3328
#define XB_TOPGEN   3392
#define XCD_BAR_WORDS 3456
#define XB_SPIN_CAP (1u << 18)
DI unsigned xb_ld(unsigned* p)              { return __hip_atomic_load(p, __ATOMIC_RELAXED, __HIP_MEMORY_SCOPE_AGENT); }
DI unsigned xb_add(unsigned* p, unsigned v) { return __hip_atomic_fetch_add(p, v, __ATOMIC_RELAXED, __HIP_MEMORY_SCOPE_AGENT); }
DI unsigned xb_xcc_id() { return (unsigned)__builtin_amdgcn_s_getreg((3 << 11) | 20) & 0xFu; }
#define XB_SPIN(cond, bar) do { unsigned _sp = 0; while (cond) { __builtin_amdgcn_s_sleep(1); \
    if ((++_sp & 255u) == 0u) { if (xb_ld(&(bar)[XB_TMO])) break; if (_sp > XB_SPIN_CAP) { atomicAdd(&(bar)[XB_TMO], 1u); break; } } } } while (0)
struct XcdBarrier { unsigned* bar; unsigned x; volatile LAS unsigned* st; };
DI XcdBarrier xcd_barrier_post(unsigned* bar, volatile LAS unsigned* st) {
    XcdBarrier b; b.bar = bar; b.x = xb_xcc_id(); b.st = st;
    if (threadIdx.x == 0) (void)xb_add(&bar[XB_XCNT(b.x)], 1u);
    return b;
}
DI void xcd_barrier_complete(unsigned* bar, unsigned x, unsigned& nloc, unsigned& nx) {
    const unsigned G = gridDim.x * gridDim.y * gridDim.z;
    unsigned sum, cnt, mine, sp = 0u;
    for (;;) {
        sum = 0u; cnt = 0u; mine = 0u;
#pragma unroll
        for (unsigned j = 0; j < 16; ++j) { const unsigned c = xb_ld(&bar[XB_XCNT(j)]); sum += c; cnt += (c > 0u) ? 1u : 0u; mine = (j == x) ? c : mine; }
        if (sum == G) break;
        __builtin_amdgcn_s_sleep(1);
        if ((++sp & 255u) == 0u) { if (xb_ld(&bar[XB_TMO])) break; if (sp > XB_SPIN_CAP) { atomicAdd(&bar[XB_TMO], 1u); break; } }
    }
    nloc = mine > 0u ? mine : 1u; nx = cnt > 0u ? cnt : 1u;
}
DI void xcd_barrier(const XcdBarrier& b) {
    asm volatile("s_waitcnt vmcnt(0)" ::: "memory");
    __syncthreads();
    if (threadIdx.x == 0) {
        unsigned* bar = b.bar;
        __builtin_amdgcn_s_waitcnt(0);
        unsigned nloc = b.st[0], nx = b.st[1];
        if (nloc == 0u) { xcd_barrier_complete(bar, b.x, nloc, nx); b.st[0] = nloc; b.st[1] = nx; }
        const unsigned old = xb_add(&bar[XB_XSUB(b.x)], 1u);
        const unsigned gen = old / nloc;
        if (old + 1u == (gen + 1u) * nloc) {
            __builtin_amdgcn_fence(__ATOMIC_RELEASE, "agent");
            asm volatile("s_waitcnt vmcnt(0)" ::: "memory");
            const unsigned og = xb_add(&bar[XB_TOP], 1u);
            const unsigned tg = og / nx;
            if (og + 1u == (tg + 1u) * nx) xb_add(&bar[XB_TOPGEN], 1u);
            else XB_SPIN(xb_ld(&bar[XB_TOPGEN]) == tg, bar);
            __builtin_amdgcn_fence(__ATOMIC_ACQUIRE, "agent");
            xb_add(&bar[XB_XGEN(b.x)], 1u);
            asm volatile("s_waitcnt vmcnt(0)" ::: "memory");
        } else {
            XB_SPIN(xb_ld(&bar[XB_XGEN(b.x)]) == gen, bar);
            __builtin_amdgcn_fence(__ATOMIC_ACQUIRE, "agent");
            asm volatile("s_waitcnt vmcnt(0)" ::: "memory");
        }
    }
    __syncthreads();
}

#ifndef REP_PREP
#define REP_PREP 1
#endif
#ifndef REP_NORM
#define REP_NORM 1
#endif
#ifndef REP_ATT
#define REP_ATT 1
#endif
#ifndef REP_S5
#define REP_S5 1
#endif
#ifndef REP_SYNC
#define REP_SYNC 1
#endif
#define GSYNC() do { for (int rs_ = 0; rs_ < REP_SYNC; ++rs_) xcd_barrier(xbar); } while (0)
struct Params { const float* in[23]; float* out; unsigned char* ws; };
template <int OFF> DI unsigned long long karg_u64() { unsigned long long v; auto ka = __builtin_amdgcn_kernarg_segment_ptr();
    asm volatile("s_load_dwordx2 %0, %1, %2\n\ts_waitcnt lgkmcnt(0)" : "=s"(v) : "s"(ka), "n"(OFF) : "memory"); return v; }
#define ARG_IN(i) ((const float*)(const __attribute__((address_space(1))) float*)karg_u64<8 * (i)>())
#define ARG_OUT() ((float*)(__attribute__((address_space(1))) float*)karg_u64<8 * 23>())
#define ARG_WS() ((unsigned char*)(__attribute__((address_space(1))) unsigned char*)karg_u64<8 * 24>())

__global__ void __launch_bounds__(512, 2) fwd_megakernel(Params p) {
    extern __shared__ __attribute__((aligned(16))) unsigned char lds_raw[];
    LAS unsigned char* lds = (LAS unsigned char*)lds_raw;
    cg::grid_group grid = cg::this_grid();
    const int G = gridDim.x, bid = blockIdx.x;
    if (threadIdx.x < 16) ((LAS unsigned*)(lds + LDS_MISC))[threadIdx.x] = 0u;
    if (bid == 0) { unsigned* bw = (unsigned*)(ARG_WS() + WS_BAR); for (int i = threadIdx.x; i < XCD_BAR_WORDS; i += 512) bw[i] = 0u; }
    __syncthreads();
#define IDS() int tidk = threadIdx.x; asm volatile("" : "+v"(tidk)); const int lane = tidk & 63, wave = __builtin_amdgcn_readfirstlane(tidk >> 6); \
    const int gw = bid * 8 + wave, NGW = G * 8, gt = bid * 512 + tidk, NT = G * 512; (void)lane; (void)gw; (void)NGW; (void)gt; (void)NT

    for (int rep_ = 0; rep_ < REP_PREP; ++rep_) {
        IDS(); unsigned char* ws = ARG_WS();
        LAS float* scr = (LAS float*)(lds + wave * 16384);
        { const float* w13 = ARG_IN(2); for (int i = 0; i < 4; ++i) conv_matrix(w13 + (size_t)i * DM * 2 * DFF, 2 * DFF, DM, 2 * DFF, (bf16_t*)(ws + WS_W13T + i * SZ_W13T), 1, gw, NGW, scr, lane); }
        { const float* w2 = ARG_IN(3); for (int i = 0; i < 4; ++i) conv_matrix(w2 + (size_t)i * DFF * DM, DM, DFF, DM, (bf16_t*)(ws + WS_W2T + i * SZ_W2T), 0, gw, NGW, scr, lane); }
        for (int l = 0; l < 2; ++l) {
            bf16_t* wc = (bf16_t*)(ws + WS_WCOMB + l * SZ_WCOMB);
            conv_matrix(ARG_IN(4) + (size_t)l * DM * DIN, DIN, DM, DIN, wc, 2, gw, NGW, scr, lane);
            conv_matrix(ARG_IN(19) + (size_t)l * DM * NGATE, NGATE, DM, NGATE, wc + (size_t)DIN * DM, 0, gw, NGW, scr, lane);
            conv_matrix(ARG_IN(13) + (size_t)l * DSSM * DSSM, DSSM, DSSM, DSSM, (bf16_t*)(ws + WS_WGLU + l * SZ_WGLU), 0, gw, NGW, scr, lane);
            bf16_t* wb = (bf16_t*)(ws + WS_WBR + l * SZ_WBR); const float* wbs = ARG_IN(18) + (size_t)l * DM * DM;
            conv_matrix(wbs, DM, DM, DM, wb, 0, gw, NGW, scr, lane);
            conv_matrix(ARG_IN(21) + (size_t)l * DM * DM, DM, DM, DM, (bf16_t*)(ws + WS_WOUT + l * SZ_WOUT), 0, gw, NGW, scr, lane);
        }
        float* COS = (float*)(ws + WS_ROPE); float* SIN = COS + SEQ * 32;
        for (int idx = gt; idx < SEQ * 32; idx += NT) { const int pos = idx >> 5, d = idx & 31; const float inv = powf(10000.0f, -(float)(2 * d) / 64.0f); const float ang = (float)pos * inv; COS[idx] = cosf(ang); SIN[idx] = sinf(ang); }
    }
    grid.sync();
    XcdBarrier xbar = xcd_barrier_post((unsigned*)(ARG_WS() + WS_BAR), (volatile LAS unsigned*)(lds + LDS_MISC));

    for (int l = 0; l < DEPTH; ++l) {
        { IDS(); unsigned char* ws = ARG_WS();
          if (l == 0) norm_rows<false>(ARG_IN(0), ARG_IN(1) + (size_t)(l * 3 + 0) * DM, ws + WS_H, gw, NGW, lane);
          else norm_rows_b<false>((const bf16_t*)(ws + WS_X), ARG_IN(1) + (size_t)(l * 3 + 0) * DM, ws + WS_H, gw, NGW, lane); }
        GSYNC();
        { unsigned char* ws = ARG_WS(); pg8::Gemm g{(const bf16_t*)(ws + WS_H), (const bf16_t*)(ws + WS_W13T + (size_t)(l * 2 + 0) * SZ_W13T), M, 2 * DFF, DM}; pg8::StaticOrder S; S.init(M, 2 * DFF, G, bid);
          pg8::EpiSwiglu E{(bf16_t*)(ws + WS_ACT)}; pg8::gemm_phase(lds, g, S, E); }
        GSYNC();
        { unsigned char* ws = ARG_WS();
          pg8::Gemm g{(const bf16_t*)(ws + WS_ACT), (const bf16_t*)(ws + WS_W2T + (size_t)(l * 2 + 0) * SZ_W2T), M, DM, DFF}; pg8::StaticOrder S; S.init(M, DM, G, bid);
          if (l == 0) { pg8::EpiResid<true> E{(const void*)ARG_IN(0), (bf16_t*)(ws + WS_X), 0.5f}; pg8::gemm_phase(lds, g, S, E); }
          else { pg8::EpiResid<false> E{(const void*)(ws + WS_X), (bf16_t*)(ws + WS_X), 0.5f}; pg8::gemm_phase(lds, g, S, E); } }
        GSYNC();
        for (int rep_ = 0; rep_ < REP_NORM; ++rep_) { IDS(); unsigned char* ws = ARG_WS(); norm_rows_b<false>((const bf16_t*)(ws + WS_X), ARG_IN(1) + (size_t)(l * 3 + 1) * DM, ws + WS_H, gw, NGW, lane); }
        GSYNC();
        { unsigned char* ws = ARG_WS(); pg8::Gemm g{(const bf16_t*)(ws + WS_H), (const bf16_t*)(ws + WS_WCOMB + (size_t)l * SZ_WCOMB), M, NCOMB, DM}; pg8::StaticOrder S; S.init(M, NCOMB, G, bid);
          pg8::EpiInGate E{ws, ARG_IN(20) + (size_t)l * NGATE};
          pg8::gemm_phase(lds, g, S, E); }
        GSYNC();
        for (int rep_ = 0; rep_ < REP_S5; ++rep_) { IDS(); unsigned char* ws = ARG_WS();
          s5_pass1(lds, (const float*)(ws + WS_U), (float*)(ws + WS_SE), ARG_IN(5) + (size_t)l * 4096, ARG_IN(6) + (size_t)l * 4096, ARG_IN(7) + (size_t)l * 64,
                   ARG_IN(8) + (size_t)l * 32768, ARG_IN(9) + (size_t)l * 32768, gw, NGW);
          conv_phase((const bf16_t*)(ws + WS_BG), (const bf16_t*)(ws + WS_CG), (const bf16_t*)(ws + WS_XV), ARG_IN(17) + (size_t)l * 3 * DCONV, (bf16_t*)(ws + WS_YA) + (DSSM + DATT), gt, NT); }
        GSYNC();
        for (int rep_ = 0; rep_ < REP_ATT; ++rep_) { unsigned char* ws = ARG_WS(); const float lambda_init = 0.8f - 0.6f * expf(-0.3f * (float)l);
          const int vcu = (G % 8 == 0) ? (bid % 8) * (G / 8) + bid / 8 : bid;
          attn_phase(lds, (const bf16_t*)(ws + WS_Q), (const bf16_t*)(ws + WS_K), (const bf16_t*)(ws + WS_V), (bf16_t*)(ws + WS_YA) + DSSM, ARG_IN(15) + (size_t)l * 256, ARG_IN(16) + (size_t)l * 128, lambda_init, vcu, G); }
        for (int rep_ = 0; rep_ < REP_S5; ++rep_) { IDS(); unsigned char* ws = ARG_WS();
          s5_pass2(lds, (const float*)(ws + WS_U), (const float*)(ws + WS_SE), (bf16_t*)(ws + WS_YG), ARG_IN(5) + (size_t)l * 4096, ARG_IN(6) + (size_t)l * 4096, ARG_IN(7) + (size_t)l * 64,
                   ARG_IN(8) + (size_t)l * 32768, ARG_IN(9) + (size_t)l * 32768, ARG_IN(10) + (size_t)l * 32768, ARG_IN(11) + (size_t)l * 32768, ARG_IN(12) + (size_t)l * DSSM, gw, NGW); }
        GSYNC();
        { unsigned char* ws = ARG_WS(); pg8::Gemm g{(const bf16_t*)(ws + WS_YG), (const bf16_t*)(ws + WS_WGLU + (size_t)l * SZ_WGLU), M, DSSM, DSSM}; pg8::StaticOrder S; S.init(M, DSSM, G, bid);
          pg8::EpiGLU E{(const bf16_t*)(ws + WS_YG), (bf16_t*)(ws + WS_YA), ARG_IN(14) + (size_t)l * DSSM}; pg8::gemm_phase(lds, g, S, E); }
        GSYNC();
        { unsigned char* ws = ARG_WS(); const bf16_t* wb = (const bf16_t*)(ws + WS_WBR + (size_t)l * SZ_WBR); pg8::StaticOrder S; S.init(M, DM, G, bid);
          pg8::Gemm g{(const bf16_t*)(ws + WS_YA), wb, M, DM, DM}; pg8::EpiBranchAll E{(const unsigned char*)(ws + WS_GATE), (bf16_t*)(ws + WS_MB)}; pg8::BranchOrder BO{S}; pg8::gemm_phase<pg8::EpiBranchAll, pg8::BranchOrder>(lds, g, BO, E); }
        GSYNC();
        { unsigned char* ws = ARG_WS(); pg8::Gemm g{(const bf16_t*)(ws + WS_MB), (const bf16_t*)(ws + WS_WOUT + (size_t)l * SZ_WOUT), M, DM, DM}; pg8::StaticOrder S; S.init(M, DM, G, bid);
          pg8::EpiResid<false> E{(const void*)(ws + WS_X), (bf16_t*)(ws + WS_X), 1.0f}; pg8::gemm_phase(lds, g, S, E); }
        GSYNC();
        for (int rep_ = 0; rep_ < REP_NORM; ++rep_) { IDS(); unsigned char* ws = ARG_WS(); norm_rows_b<false>((const bf16_t*)(ws + WS_X), ARG_IN(1) + (size_t)(l * 3 + 2) * DM, ws + WS_H, gw, NGW, lane); }
        GSYNC();
        { unsigned char* ws = ARG_WS(); pg8::Gemm g{(const bf16_t*)(ws + WS_H), (const bf16_t*)(ws + WS_W13T + (size_t)(l * 2 + 1) * SZ_W13T), M, 2 * DFF, DM}; pg8::StaticOrder S; S.init(M, 2 * DFF, G, bid);
          pg8::EpiSwiglu E{(bf16_t*)(ws + WS_ACT)}; pg8::gemm_phase(lds, g, S, E); }
        GSYNC();
        { unsigned char* ws = ARG_WS(); pg8::Gemm g{(const bf16_t*)(ws + WS_ACT), (const bf16_t*)(ws + WS_W2T + (size_t)(l * 2 + 1) * SZ_W2T), M, DM, DFF}; pg8::StaticOrder S; S.init(M, DM, G, bid);
          pg8::EpiResid<false> E{(const void*)(ws + WS_X), (bf16_t*)(ws + WS_X), 0.5f}; pg8::gemm_phase(lds, g, S, E); }
        GSYNC();
    }
    for (int rep_ = 0; rep_ < REP_NORM; ++rep_) { IDS(); unsigned char* ws = ARG_WS(); norm_rows_b<true>((const bf16_t*)(ws + WS_X), ARG_IN(22), ARG_OUT(), gw, NGW, lane); }
}

extern "C" void kernel_launch(void* const* d_in, const int* in_sizes, int n_in, void* d_out, int out_size, void* d_ws, size_t ws_size, hipStream_t stream) {
    static int grid_blocks = 0;
    if (!grid_blocks) {
        if (n_in != 23 || out_size != M * DM || ws_size < WS_END) { fprintf(stderr, "kernel_launch: unexpected problem (n_in %d out %d ws %zu need %zu)\n", n_in, out_size, ws_size, (size_t)WS_END); grid_blocks = -1; return; }
        int dev = 0, cus = 0, per_cu = 0;
        (void)hipGetDevice(&dev);
        (void)hipDeviceGetAttribute(&cus, hipDeviceAttributeMultiprocessorCount, dev);
        (void)hipFuncSetAttribute((const void*)fwd_megakernel, hipFuncAttributeMaxDynamicSharedMemorySize, LDS_BYTES);
        (void)hipOccupancyMaxActiveBlocksPerMultiprocessor(&per_cu, (const void*)fwd_megakernel, 512, LDS_BYTES);
        if (per_cu < 1) per_cu = 1;
        grid_blocks = cus * per_cu;
    }
    if (grid_blocks < 0) return;
    Params p{};
    for (int i = 0; i < 23; ++i) p.in[i] = (const float*)d_in[i];
    p.out = (float*)d_out; p.ws = (unsigned char*)d_ws;
    void* args[] = {&p};
    hipError_t e = hipLaunchCooperativeKernel((void*)fwd_megakernel, dim3(grid_blocks), dim3(512), args, LDS_BYTES, stream);
    if (e != hipSuccess) fprintf(stderr, "cooperative launch failed: %s (grid %d)\n", hipGetErrorString(e), grid_blocks);
}
```
